# Optimizing an MI355X kernel written in HIP

```python
import math
import jax
import jax.numpy as jnp
from jax import lax
import numpy as np

D_MODEL = 1024
BATCH = 32
SEQ = 256
DEPTH = 2
DEC_BATCH = 2
DEC_SEQ = 4096
PAST_LEN = 256

GRID_W = 64
EPS = 1e-6
ROPE_THETA = 10000.0
CHUNK = 128
Q_BLOCK = 128
ATT_HEAD_DIM = 64
ATT_WIDTH = D_MODEL // 2
ATT_HEADS = ATT_WIDTH // ATT_HEAD_DIM
ATT_KV_HEADS = ATT_HEADS // 4
ATT_KV_WIDTH = ATT_KV_HEADS * ATT_HEAD_DIM
SSD_WIDTH = D_MODEL // 2
SSD_HEAD_DIM = 64
SSD_HEADS = SSD_WIDTH // SSD_HEAD_DIM
SSD_GROUPS = 2
SSD_STATE = 64
SSD_CONV = 5
SSD_XBC = SSD_WIDTH + 2 * SSD_GROUPS * SSD_STATE
L0_IN = ATT_WIDTH + 2 * ATT_KV_WIDTH + SSD_WIDTH + SSD_XBC + 2 * SSD_HEADS
RET_HEADS = 4
RET_QK_WIDTH = D_MODEL
RET_V_WIDTH = 2 * D_MODEL
RET_DK = RET_QK_WIDTH // RET_HEADS
RET_DV = RET_V_WIDTH // RET_HEADS
L1_IN = 2 * RET_QK_WIDTH + 2 * RET_V_WIDTH
D_FF = -(-8 * D_MODEL // (3 * 256)) * 256

kernel_name = "hybrid_ssd_gqa_retention_diffusion_step"

F32 = jnp.float32


def rmsnorm(x, w):
    xf = x.astype(F32)
    y = xf * lax.rsqrt(jnp.mean(xf * xf, axis=-1, keepdims=True) + EPS)
    return (y * w.astype(F32)).astype(x.dtype)


def axial_rope(n_tokens, dim):
    rows = n_tokens // GRID_W
    row = jnp.repeat(jnp.arange(rows), GRID_W).astype(F32)
    col = jnp.tile(jnp.arange(GRID_W), rows).astype(F32)
    n_freq = dim // 4
    inv = ROPE_THETA ** (-jnp.arange(n_freq, dtype=F32) / n_freq)
    ang = jnp.concatenate([row[:, None] * inv, col[:, None] * inv], axis=-1)
    return jnp.cos(ang)[:, None, :], jnp.sin(ang)[:, None, :]


def apply_rope(x, rope):
    cos, sin = rope[0].astype(x.dtype), rope[1].astype(x.dtype)
    x1, x2 = jnp.split(x, 2, axis=-1)
    return jnp.concatenate([x1 * cos - x2 * sin, x2 * cos + x1 * sin], axis=-1)


def block_attention(q, k, v):
    b, lq, nkv, g, d = q.shape
    nb = lq // Q_BLOCK
    qb = q.reshape(b, nb, Q_BLOCK, nkv, g, d).swapaxes(0, 1)
    scale = d ** -0.5

    def one(qblk):
        s = jnp.einsum("bqkgd,btkd->bkgqt", qblk, k).astype(F32) * scale
        p = jax.nn.softmax(s, axis=-1).astype(v.dtype)
        return jnp.einsum("bkgqt,btkd->bqkgd", p, v)

    o = lax.map(one, qb)
    return o.swapaxes(0, 1).reshape(b, lq, nkv * g * d)


def dwconv_centred(x, w, bias):
    kw, ch = w.shape
    y = lax.conv_general_dilated(x, w[:, None, :].astype(x.dtype), window_strides=(1,),
                                 padding=[(kw // 2, kw // 2)],
                                 dimension_numbers=("NWC", "WIO", "NWC"),
                                 feature_group_count=ch)
    return y + bias


def chunked_decay_scan(q, k, v, log_a, s0):
    b, l, h, dk = q.shape
    dv = v.shape[-1]
    nc = l // CHUNK

    def to_chunks(t):
        return t.reshape((b, nc, CHUNK) + t.shape[2:]).swapaxes(0, 1)

    idx = jnp.arange(CHUNK)
    lower = idx[:, None] >= idx[None, :]

    def step(s, xs):
        qc, kc, vc, ac = xs
        cum = jnp.cumsum(ac.astype(F32), axis=1)
        cum_h = cum.transpose(0, 2, 1)
        decay = jnp.exp(jnp.where(lower, cum_h[..., :, None] - cum_h[..., None, :], -jnp.inf)).astype(qc.dtype)
        scores = jnp.einsum("bihd,bjhd->bhij", qc, kc) * decay
        y = (jnp.einsum("bhij,bjhe->bihe", scores, vc)
             + jnp.einsum("bihd,bhde->bihe", qc * jnp.exp(cum)[..., None].astype(qc.dtype), s))
        total = cum[:, -1]
        w_in = jnp.exp(total[:, None, :] - cum).astype(kc.dtype)
        s_new = (s * jnp.exp(total)[..., None, None].astype(s.dtype)
                 + jnp.einsum("bjhd,bjhe->bhde", kc * w_in[..., None], vc)).astype(s.dtype)
        return s_new, y

    s_fin, ys = lax.scan(step, s0, (to_chunks(q), to_chunks(k), to_chunks(v), to_chunks(log_a)))
    return ys.swapaxes(0, 1).reshape(b, l, h, dv), s_fin


def bidir_scan(q, k, v_f, v_b, a_f, a_b, s0):
    flip = lambda t: jnp.flip(t, axis=1)
    y_f, s_f = chunked_decay_scan(q, k, v_f, a_f, s0[:, 0])
    y_b, s_b = chunked_decay_scan(flip(q), flip(k), flip(v_b), flip(a_b), s0[:, 1])
    return y_f + flip(y_b), jnp.stack([s_f, s_b], axis=1)


def mixer_ab(h, w_in, w_out, q_gain, k_gain, conv_w, conv_b, dt_bias, a_log, d_skip, ssd_gain,
             s0, rope, cache_k, cache_v):
    b, l, _ = h.shape
    o1 = ATT_WIDTH
    o2 = o1 + ATT_KV_WIDTH
    o3 = o2 + ATT_KV_WIDTH
    o4 = o3 + SSD_WIDTH
    o5 = o4 + SSD_XBC
    q, k, v, z, xbc, dt = jnp.split(h @ w_in, [o1, o2, o3, o4, o5], axis=-1)
    q = rmsnorm(q.reshape(b, l, ATT_HEADS, ATT_HEAD_DIM), q_gain)
    k = rmsnorm(k.reshape(b, l, ATT_KV_HEADS, ATT_HEAD_DIM), k_gain)
    v = v.reshape(b, l, ATT_KV_HEADS, ATT_HEAD_DIM)
    k_ctx, v_ctx = k, v
    if rope is None:
        k_all, v_all = k, v
    else:
        q = apply_rope(q, rope)
        k_all = jnp.concatenate([cache_k, apply_rope(k, rope)], axis=1)
        v_all = jnp.concatenate([cache_v, v], axis=1)
    att = block_attention(q.reshape(b, l, ATT_KV_HEADS, ATT_HEADS // ATT_KV_HEADS, ATT_HEAD_DIM), k_all, v_all)
    xbc = jax.nn.silu(dwconv_centred(xbc, conv_w, conv_b))
    xs, bm, cm = jnp.split(xbc, [SSD_WIDTH, SSD_WIDTH + SSD_GROUPS * SSD_STATE], axis=-1)
    xs = xs.reshape(b, l, SSD_HEADS, SSD_HEAD_DIM)
    rep = SSD_HEADS // SSD_GROUPS
    bm = jnp.repeat(bm.reshape(b, l, SSD_GROUPS, SSD_STATE), rep, axis=2)
    cm = jnp.repeat(cm.reshape(b, l, SSD_GROUPS, SSD_STATE), rep, axis=2)
    dt = jax.nn.softplus(dt.reshape(b, l, 2, SSD_HEADS) + dt_bias)
    a = dt * (-jnp.exp(a_log))
    y, s_fin = bidir_scan(cm, bm, xs * dt[:, :, 0, :, None], xs * dt[:, :, 1, :, None],
                          a[:, :, 0], a[:, :, 1], s0)
    y = y + d_skip[:, None] * xs
    y = rmsnorm(y.reshape(b, l, SSD_WIDTH) * jax.nn.silu(z), ssd_gain)
    out = jnp.concatenate([att, y], axis=-1) @ w_out
    return out, k_ctx, v_ctx, s_fin


def mixer_c(h, w_in, w_out, decay, ret_gain, s0, rope):
    b, l, _ = h.shape
    q, k, v, g = jnp.split(h @ w_in, [RET_QK_WIDTH, 2 * RET_QK_WIDTH, 2 * RET_QK_WIDTH + RET_V_WIDTH], axis=-1)
    q = q.reshape(b, l, RET_HEADS, RET_DK)
    k = k.reshape(b, l, RET_HEADS, RET_DK) * (RET_DK ** -0.5)
    v = v.reshape(b, l, RET_HEADS, RET_DV)
    if rope is not None:
        q = apply_rope(q, rope)
        k = apply_rope(k, rope)
    log_g = (-jnp.exp(decay)).astype(h.dtype)
    a_f = jnp.broadcast_to(log_g[0], (b, l, RET_HEADS))
    a_b = jnp.broadcast_to(log_g[1], (b, l, RET_HEADS))
    y, s_fin = bidir_scan(q, k, v, v, a_f, a_b, s0)
    y = rmsnorm(y, ret_gain.reshape(RET_HEADS, RET_DV))
    out = (jax.nn.silu(g) * y.reshape(b, l, RET_V_WIDTH)) @ w_out
    return out, s_fin


def swiglu(h, w_gate, w_up, w_down):
    return (jax.nn.silu(h @ w_gate) * (h @ w_up)) @ w_down


def setup_inputs(seed: int = 0) -> dict:
    key = jax.random.key(seed)
    ks = iter(jax.random.split(key, 64))
    d = D_MODEL

    def nrm(shape, scale=1.0):
        return jax.random.normal(next(ks), shape, F32) * scale

    def gain(n):
        return 1.0 + nrm((n,), 0.02)

    dt0 = jnp.exp(jax.random.uniform(next(ks), (2, SSD_HEADS), F32, math.log(1e-3), math.log(1e-1)))
    ret_base = jnp.log(-jnp.log1p(-(2.0 ** (-5.0 - jnp.arange(RET_HEADS, dtype=F32)))))
    inp = {}
    inp["x_prompt"] = nrm((BATCH, SEQ, d))
    inp["x_sample"] = nrm((DEC_BATCH, DEC_SEQ, d))
    inp["c"] = nrm((DEC_BATCH, d))
    inp["cache_k0"] = nrm((DEC_BATCH, PAST_LEN, ATT_KV_HEADS, ATT_HEAD_DIM))
    inp["cache_v0"] = nrm((DEC_BATCH, PAST_LEN, ATT_KV_HEADS, ATT_HEAD_DIM))
    inp["state_ssd0"] = nrm((DEC_BATCH, 2, SSD_HEADS, SSD_STATE, SSD_HEAD_DIM), 0.5)
    inp["state_ret1"] = nrm((DEC_BATCH, 2, RET_HEADS, RET_DK, RET_DV), 0.5)
    inp["c_ctx"] = nrm((d,))
    inp["l0_w_ada"] = nrm((d, 6 * d), d ** -0.5)
    inp["l0_b_ada"] = nrm((6 * d,), 0.02)
    inp["l0_norm_mix"] = gain(d)
    inp["l0_norm_ffn"] = gain(d)
    inp["l0_w_in"] = nrm((d, L0_IN), d ** -0.5)
    inp["l0_w_out"] = nrm((ATT_WIDTH + SSD_WIDTH, d), (ATT_WIDTH + SSD_WIDTH) ** -0.5)
    inp["l0_q_gain"] = gain(ATT_HEAD_DIM)
    inp["l0_k_gain"] = gain(ATT_HEAD_DIM)
    inp["l0_conv_w"] = nrm((SSD_CONV, SSD_XBC), SSD_CONV ** -0.5)
    inp["l0_conv_b"] = nrm((SSD_XBC,), 0.02)
    inp["l0_dt_bias"] = dt0 + jnp.log(-jnp.expm1(-dt0))
    inp["l0_a_log"] = jnp.log(jax.random.uniform(next(ks), (2, SSD_HEADS), F32, 1.0, 16.0))
    inp["l0_d_skip"] = 1.0 + nrm((SSD_HEADS,), 0.1)
    inp["l0_ssd_gain"] = gain(SSD_WIDTH)
    inp["l0_w_gate"] = nrm((d, D_FF), d ** -0.5)
    inp["l0_w_up"] = nrm((d, D_FF), d ** -0.5)
    inp["l0_w_down"] = nrm((D_FF, d), D_FF ** -0.5)
    inp["l1_w_ada"] = nrm((d, 6 * d), d ** -0.5)
    inp["l1_b_ada"] = nrm((6 * d,), 0.02)
    inp["l1_norm_mix"] = gain(d)
    inp["l1_norm_ffn"] = gain(d)
    inp["l1_w_in"] = nrm((d, L1_IN), d ** -0.5)
    inp["l1_w_out"] = nrm((RET_V_WIDTH, d), RET_V_WIDTH ** -0.5)
    inp["l1_decay"] = ret_base[None, :] + nrm((2, RET_HEADS), 0.1)
    inp["l1_ret_gain"] = gain(RET_V_WIDTH)
    inp["l1_w_gate"] = nrm((d, D_FF), d ** -0.5)
    inp["l1_w_up"] = nrm((d, D_FF), d ** -0.5)
    inp["l1_w_down"] = nrm((D_FF, d), D_FF ** -0.5)
    inp["final_norm"] = gain(d)
    return inp


def reference(x_prompt, x_sample, c, cache_k0, cache_v0, state_ssd0, state_ret1, c_ctx,
              l0_w_ada, l0_b_ada, l0_norm_mix, l0_norm_ffn, l0_w_in, l0_w_out, l0_q_gain, l0_k_gain,
              l0_conv_w, l0_conv_b, l0_dt_bias, l0_a_log, l0_d_skip, l0_ssd_gain,
              l0_w_gate, l0_w_up, l0_w_down,
              l1_w_ada, l1_b_ada, l1_norm_mix, l1_norm_ffn, l1_w_in, l1_w_out, l1_decay, l1_ret_gain,
              l1_w_gate, l1_w_up, l1_w_down, final_norm):
    layers = (
        dict(w_ada=l0_w_ada, b_ada=l0_b_ada, norm_mix=l0_norm_mix, norm_ffn=l0_norm_ffn,
             w_gate=l0_w_gate, w_up=l0_w_up, w_down=l0_w_down),
        dict(w_ada=l1_w_ada, b_ada=l1_b_ada, norm_mix=l1_norm_mix, norm_ffn=l1_norm_ffn,
             w_gate=l1_w_gate, w_up=l1_w_up, w_down=l1_w_down),
    )

    def trunk(x, cond, rope_att, rope_ret, caches):
        b = x.shape[0]
        ctx_out = []
        for i in range(DEPTH):
            p = layers[i]
            mod = (jax.nn.silu(cond) @ p["w_ada"] + p["b_ada"])[:, None, :]
            sh1, sc1, g1, sh2, sc2, g2 = jnp.split(mod, 6, axis=-1)
            h = rmsnorm(x, p["norm_mix"]) * (1.0 + sc1) + sh1
            if i % 2 == 0:
                if caches is None:
                    ck, cv = None, None
                    s0 = jnp.zeros((b, 2, SSD_HEADS, SSD_STATE, SSD_HEAD_DIM), x.dtype)
                else:
                    ck, cv, s0 = caches[i]
                mix, k_ctx, v_ctx, s_fin = mixer_ab(h, l0_w_in, l0_w_out, l0_q_gain, l0_k_gain, l0_conv_w,
                                                    l0_conv_b, l0_dt_bias, l0_a_log, l0_d_skip, l0_ssd_gain,
                                                    s0, rope_att, ck, cv)
                ctx_out += [k_ctx, v_ctx, s_fin]
            else:
                if caches is None:
                    s0 = jnp.zeros((b, 2, RET_HEADS, RET_DK, RET_DV), x.dtype)
                else:
                    s0 = caches[i][0]
                mix, s_fin = mixer_c(h, l1_w_in, l1_w_out, l1_decay, l1_ret_gain, s0, rope_ret)
                ctx_out += [s_fin]
            x = x + g1 * mix
            h = rmsnorm(x, p["norm_ffn"]) * (1.0 + sc2) + sh2
            x = x + g2 * swiglu(h, p["w_gate"], p["w_up"], p["w_down"])
        return rmsnorm(x, final_norm), ctx_out

    y_prompt, ctx = trunk(x_prompt, c_ctx[None, :], None, None, None)
    new_k0, new_v0, new_ssd0, new_ret1 = ctx
    n_lat = x_sample.shape[1]
    rope_att = axial_rope(n_lat, ATT_HEAD_DIM)
    rope_ret = axial_rope(n_lat, RET_DK)
    caches = ((cache_k0, cache_v0, state_ssd0), (state_ret1,))
    y_sample, _ = trunk(x_sample, c, rope_att, rope_ret, caches)
    return (y_prompt, y_sample, new_k0, new_v0, new_ssd0, new_ret1)
```

```cpp
#include <hip/hip_runtime.h>
#include <hip/hip_cooperative_groups.h>
#include <cstdio>
namespace cg = cooperative_groups;

#ifndef ONE_LAUNCH
#define ONE_LAUNCH 1
#endif

#ifndef PH_LIMIT_MASK
#define PH_LIMIT_MASK 0x2000
#endif
#ifndef REPEAT_MASK
#define REPEAT_MASK 0
#endif
#ifndef REPEAT_N
#define REPEAT_N 1
#endif
#ifndef LB_MIN
#define LB_MIN 2
#endif
#define DI __device__ __forceinline__
typedef unsigned short bf16_t;
using bf16x8 = __attribute__((ext_vector_type(8))) short;
using f32x4 = __attribute__((ext_vector_type(4))) float;

constexpr int NTOK = 16384;
constexpr int NCTX = 8192;
constexpr int DM = 1024;
constexpr int DFF = 2816;
constexpr float EPSF = 1e-6f;
constexpr int NPH = 23;

constexpr size_t MBy = 1048576;
constexpr size_t OFF_WIN0 = 0;
constexpr size_t OFF_WOUT0 = OFF_WIN0 + (size_t)2176 * 1024 * 2;
constexpr size_t OFF_WGU0 = OFF_WOUT0 + (size_t)1024 * 1024 * 2;
constexpr size_t OFF_WDN0 = OFF_WGU0 + (size_t)5632 * 1024 * 2;
constexpr size_t OFF_WIN1 = OFF_WDN0 + (size_t)1024 * 2816 * 2;
constexpr size_t OFF_WOUT1 = OFF_WIN1 + (size_t)6144 * 1024 * 2;
constexpr size_t OFF_WGU1 = OFF_WOUT1 + (size_t)1024 * 2048 * 2;
constexpr size_t OFF_WDN1 = OFF_WGU1 + (size_t)5632 * 1024 * 2;
constexpr size_t OFF_MOD = OFF_WDN1 + (size_t)1024 * 2816 * 2;
constexpr size_t OFF_SC0 = OFF_MOD + (size_t)2 * 3 * 6144 * 4;
constexpr size_t OFF_SC1 = OFF_SC0 + (size_t)8 * NTOK * 8 * 4;
constexpr size_t OFF_ROPE0 = OFF_SC1 + (size_t)8 * NTOK * 4 * 4;
constexpr size_t OFF_ROPE1 = OFF_ROPE0 + 8192;
constexpr size_t OFF_BAR = OFF_ROPE1 + 32768;
constexpr size_t OFF_X = 64 * MBy;
constexpr size_t OFF_H = OFF_X + 64 * MBy;
constexpr size_t OFF_R1 = OFF_H + 32 * MBy;
constexpr size_t OFF_R2 = OFF_R1 + 64 * MBy;
constexpr size_t OFF_R3 = OFF_R2 + 64 * MBy;
constexpr size_t OFF_R4 = OFF_R3 + 64 * MBy;
constexpr size_t OFF_SST1B = OFF_R4 + 128 * MBy;
constexpr size_t WS_NEED = OFF_SST1B + 32 * MBy;
static_assert(OFF_BAR + 16384 <= OFF_X, "weights region overflow");
constexpr size_t OFF_Q0 = OFF_R1;
constexpr size_t OFF_KC = OFF_Q0 + 16 * MBy;
constexpr size_t OFF_VC = OFF_KC + 2 * MBy;
constexpr size_t OFF_KL = OFF_VC + 2 * MBy;
constexpr size_t OFF_VL = OFF_KL + 3 * MBy;
constexpr size_t OFF_ZS = OFF_VL + 3 * MBy;
constexpr size_t OFF_VS = OFF_ZS + 16 * MBy;
static_assert(OFF_VS + 16 * MBy <= OFF_R2, "R1 overflow");
constexpr size_t OFF_Q1 = OFF_R1;
constexpr size_t OFF_K1 = OFF_R1 + 32 * MBy;
constexpr size_t OFF_SST1 = OFF_R1;
constexpr size_t OFF_XS = OFF_R2;
constexpr size_t OFF_YG = OFF_R2 + 32 * MBy;
constexpr size_t OFF_V1 = OFF_R2;
constexpr size_t OFF_A2 = OFF_R2;
constexpr size_t OFF_XBC = OFF_R3;
constexpr size_t OFF_DT = OFF_XBC + 48 * MBy;
constexpr size_t OFF_CC = OFF_DT + 1 * MBy;
constexpr size_t OFF_BB = OFF_CC + 4 * MBy;
static_assert(OFF_BB + 4 * MBy <= OFF_R4, "R3 overflow");
constexpr size_t OFF_G1 = OFF_R3;
constexpr size_t OFF_P0 = OFF_R4;
constexpr size_t OFF_DS0 = OFF_P0 + 64 * MBy;
constexpr size_t OFF_SST0 = OFF_DS0 + 16 * MBy;
constexpr size_t OFF_AOUT = OFF_SST0 + 8 * MBy;
static_assert(OFF_AOUT + 32 * MBy <= WS_NEED, "R4 overflow");
constexpr size_t OFF_HFF = OFF_R4;
constexpr size_t OFF_DS1 = OFF_R4;
constexpr size_t OFF_Y1 = OFF_R4;
constexpr size_t OFF_P1 = OFF_H;

constexpr size_t OUT_Y = 0;
constexpr size_t OUT_K0 = 16777216;
constexpr size_t OUT_V0 = OUT_K0 + 1048576;
constexpr size_t OUT_SSD = OUT_V0 + 1048576;
constexpr size_t OUT_RET = OUT_SSD + 2097152;

struct Params {
  const float* in[37];
  float* out;
  unsigned char* ws;
  int ph_lo, ph_hi;
  int gsz, pad_;
};

typedef __bf16 bf16x2_t __attribute__((ext_vector_type(2)));
DI bf16_t f2bf(float x) { const __bf16 h = (__bf16)x; return __builtin_bit_cast(bf16_t, h); }
DI float bf2f(bf16_t h) { return __uint_as_float(((unsigned)h) << 16); }
DI unsigned pack2(float a, float b) { const bf16x2_t v = {(__bf16)a, (__bf16)b}; return __builtin_bit_cast(unsigned, v); }
DI float siluf(float x) { return x / (1.f + __expf(-x)); }
DI unsigned scale2(unsigned w, float s) {
  float lo = __uint_as_float(w << 16) * s, hi = __uint_as_float(w & 0xffff0000u) * s;
  return pack2(lo, hi);
}
DI uint4 scale8(uint4 v, float s) {
  v.x = scale2(v.x, s); v.y = scale2(v.y, s); v.z = scale2(v.z, s); v.w = scale2(v.w, s);
  return v;
}
DI float wave_sum(float v) {
#pragma unroll
  for (int o = 32; o >= 1; o >>= 1) v += __shfl_xor(v, o, 64);
  return v;
}
DI float sum16(float v) {
  v += __shfl_xor(v, 1, 64); v += __shfl_xor(v, 2, 64); v += __shfl_xor(v, 4, 64); v += __shfl_xor(v, 8, 64);
  return v;
}
DI float max16(float v) {
  v = fmaxf(v, __shfl_xor(v, 1, 64)); v = fmaxf(v, __shfl_xor(v, 2, 64));
  v = fmaxf(v, __shfl_xor(v, 4, 64)); v = fmaxf(v, __shfl_xor(v, 8, 64));
  return v;
}
DI void sincos_rev(float ang, float& s, float& c) {
  float r = ang * 0.15915494309189535f;
  r = r - rintf(r);
  s = __builtin_amdgcn_sinf(r);
  c = __builtin_amdgcn_cosf(r);
}
DI const float* xin_row(const Params& p, int tok) {
  return tok < NCTX ? p.in[0] + (size_t)tok * DM : p.in[1] + (size_t)(tok - NCTX) * DM;
}
DI int cond_row(int tok) { return tok < NCTX ? 0 : 1 + ((tok - NCTX) >> 12); }

constexpr int LDK = 72;

template <bool TR>
DI void tile_load(const bf16_t* __restrict__ P, int ld, const float* __restrict__ sc, int ss, int lim, int k0, uint4 (&r)[4]) {
  const int tid = threadIdx.x;
#pragma unroll
  for (int i = 0; i < 4; ++i) {
    const int id = tid + i * 256;
    uint4 v = make_uint4(0u, 0u, 0u, 0u);
    if (!TR) {
      const int row = id >> 3, kc = id & 7;
      if (row < lim) {
        v = *(const uint4*)(P + (size_t)row * ld + k0 + kc * 8);
        if (sc) v = scale8(v, sc[(size_t)row * ss]);
      }
    } else {
      const int kr = id >> 4, mc = id & 15;
      if (mc * 8 < lim) {
        v = *(const uint4*)(P + (size_t)(k0 + kr) * ld + mc * 8);
        if (sc) v = scale8(v, sc[(size_t)(k0 + kr) * ss]);
      }
    }
    r[i] = v;
  }
}
template <bool TR>
DI void tile_store(bf16_t* L, const uint4 (&r)[4]) {
  const int tid = threadIdx.x;
#pragma unroll
  for (int i = 0; i < 4; ++i) {
    const int id = tid + i * 256;
    if (!TR) {
      const int row = id >> 3, kc = id & 7;
      *(uint4*)(L + row * LDK + kc * 8) = r[i];
    } else {
      const int kr = id >> 4, mc = id & 15;
      bf16_t* q = L + (mc * 8) * LDK + kr;
      q[0 * LDK] = (bf16_t)(r[i].x & 0xffffu); q[1 * LDK] = (bf16_t)(r[i].x >> 16);
      q[2 * LDK] = (bf16_t)(r[i].y & 0xffffu); q[3 * LDK] = (bf16_t)(r[i].y >> 16);
      q[4 * LDK] = (bf16_t)(r[i].z & 0xffffu); q[5 * LDK] = (bf16_t)(r[i].z >> 16);
      q[6 * LDK] = (bf16_t)(r[i].w & 0xffffu); q[7 * LDK] = (bf16_t)(r[i].w >> 16);
    }
  }
}

template <bool TRA, bool TRB>
DI void gemm_seg(const bf16_t* __restrict__ A, int lda, const float* __restrict__ sA, int ssA, int Mlim,
                 const bf16_t* __restrict__ B, int ldb, const float* __restrict__ sB, int ssB, int Nlim,
                 int K, f32x4 (&acc)[4][4], bf16_t* lA, bf16_t* lB) {
  uint4 ra[4], rb[4];
  tile_load<TRA>(A, lda, sA, ssA, Mlim, 0, ra);
  tile_load<TRB>(B, ldb, sB, ssB, Nlim, 0, rb);
  const int lane = threadIdx.x & 63, w = threadIdx.x >> 6, wm = w >> 1, wn = w & 1;
  const bf16_t* pa = lA + (wm * 64 + (lane & 15)) * LDK + (lane >> 4) * 8;
  const bf16_t* pb = lB + (wn * 64 + (lane & 15)) * LDK + (lane >> 4) * 8;
  for (int k0 = 0; k0 < K; k0 += 64) {
    __syncthreads();
    tile_store<TRA>(lA, ra);
    tile_store<TRB>(lB, rb);
    __syncthreads();
    if (k0 + 64 < K) {
      tile_load<TRA>(A, lda, sA, ssA, Mlim, k0 + 64, ra);
      tile_load<TRB>(B, ldb, sB, ssB, Nlim, k0 + 64, rb);
    }
    __builtin_amdgcn_s_setprio(1);
#pragma unroll 1
    for (int ks = 0; ks < 2; ++ks) {
      bf16x8 a[4], b[4];
#pragma unroll
      for (int t = 0; t < 4; ++t) {
        a[t] = *(const bf16x8*)(pa + t * 16 * LDK + ks * 32);
        b[t] = *(const bf16x8*)(pb + t * 16 * LDK + ks * 32);
      }
#pragma unroll
      for (int tm = 0; tm < 4; ++tm)
#pragma unroll
        for (int tn = 0; tn < 4; ++tn)
          acc[tm][tn] = __builtin_amdgcn_mfma_f32_16x16x32_bf16(a[tm], b[tn], acc[tm][tn], 0, 0, 0);
    }
    __builtin_amdgcn_s_setprio(0);
  }
}

DI void zero_acc(f32x4 (&acc)[4][4]) {
#pragma unroll
  for (int i = 0; i < 4; ++i)
#pragma unroll
    for (int j = 0; j < 4; ++j) acc[i][j] = f32x4{0.f, 0.f, 0.f, 0.f};
}

constexpr int LDK2 = 40;
DI void zero_acc8(f32x4 (&acc)[8][4]) {
#pragma unroll
  for (int i = 0; i < 8; ++i)
#pragma unroll
    for (int j = 0; j < 4; ++j) acc[i][j] = f32x4{0.f, 0.f, 0.f, 0.f};
}
DI void gemm256(const bf16_t* __restrict__ A, int lda, const bf16_t* __restrict__ B, int ldb, int K,
                f32x4 (&acc)[8][4], bf16_t* lA, bf16_t* lB) {
  const int tid = threadIdx.x;
  const int lrow = tid >> 2, kc = tid & 3;
  const bf16_t* ga = A + (size_t)lrow * lda + kc * 8;
  const bf16_t* gb = B + (size_t)lrow * ldb + kc * 8;
  const size_t sa = (size_t)64 * lda, sb = (size_t)64 * ldb;
  uint4 ra0 = *(const uint4*)(ga), ra1 = *(const uint4*)(ga + sa), ra2 = *(const uint4*)(ga + 2 * sa), ra3 = *(const uint4*)(ga + 3 * sa);
  uint4 rb0 = *(const uint4*)(gb), rb1 = *(const uint4*)(gb + sb);
  const int lane = tid & 63, w = tid >> 6, wm = w >> 1, wn = w & 1;
  const bf16_t* pa = lA + (wm * 128 + (lane & 15)) * LDK2 + (lane >> 4) * 8;
  const bf16_t* pb = lB + (wn * 64 + (lane & 15)) * LDK2 + (lane >> 4) * 8;
  bf16_t* wa = lA + lrow * LDK2 + kc * 8;
  bf16_t* wb = lB + lrow * LDK2 + kc * 8;
  for (int k0 = 0; k0 < K; k0 += 32) {
    __syncthreads();
    *(uint4*)(wa) = ra0; *(uint4*)(wa + 64 * LDK2) = ra1; *(uint4*)(wa + 128 * LDK2) = ra2; *(uint4*)(wa + 192 * LDK2) = ra3;
    *(uint4*)(wb) = rb0; *(uint4*)(wb + 64 * LDK2) = rb1;
    __syncthreads();
    if (k0 + 32 < K) {
      ga += 32; gb += 32;
      ra0 = *(const uint4*)(ga); ra1 = *(const uint4*)(ga + sa); ra2 = *(const uint4*)(ga + 2 * sa); ra3 = *(const uint4*)(ga + 3 * sa);
      rb0 = *(const uint4*)(gb); rb1 = *(const uint4*)(gb + sb);
    }
    __builtin_amdgcn_s_setprio(1);
    bf16x8 b[4];
#pragma unroll
    for (int t = 0; t < 4; ++t) b[t] = *(const bf16x8*)(pb + t * 16 * LDK2);
#pragma unroll
    for (int hf = 0; hf < 2; ++hf) {
      bf16x8 a[4];
#pragma unroll
      for (int t = 0; t < 4; ++t) a[t] = *(const bf16x8*)(pa + (hf * 4 + t) * 16 * LDK2);
#pragma unroll
      for (int tm = 0; tm < 4; ++tm)
#pragma unroll
        for (int tn = 0; tn < 4; ++tn)
          acc[hf * 4 + tm][tn] = __builtin_amdgcn_mfma_f32_16x16x32_bf16(a[tm], b[tn], acc[hf * 4 + tm][tn], 0, 0, 0);
    }
    __builtin_amdgcn_s_setprio(0);
  }
}

DI int xcd_tile(int it, int n) { return (it & 7) * (n >> 3) + (it >> 3); }

DI void wconv_tile(const float* __restrict__ W0, const float* __restrict__ W1, int type, int Kdim, int Nsrc,
                   int kt, int nt, bf16_t* __restrict__ out, float* tile) {
  const int tid = threadIdx.x;
  const int k0 = kt * 64, n0 = nt * 64;
  const int c4 = tid & 15, r = tid >> 4;
  const int np = n0 + c4 * 4;
  const float* src = W0;
  int col = np;
  bool valid = true;
  if (type == 0) {
    valid = np < Nsrc;
  } else if (type == 1) {
    const int q = np >> 5, rr = np & 31;
    src = rr < 16 ? W0 : W1;
    col = q * 16 + (rr & 15);
  } else if (type == 2) {
    valid = np < Nsrc;
    if (np < 640) {
      const int head = np >> 6, pp = np & 63, nb = pp >> 4, c = pp & 15;
      const int o = (nb == 0 ? 0 : nb == 1 ? 32 : nb == 2 ? 16 : 48) + c;
      col = head * 64 + o;
    }
  } else {
    if (np < 2048) {
      const int head = np >> 8, pp = np & 255, g = pp >> 5, rr = pp & 31;
      const int o = rr < 16 ? g * 16 + rr : 128 + g * 16 + (rr - 16);
      col = head * 256 + o;
    }
  }
  __syncthreads();
#pragma unroll
  for (int pass = 0; pass < 4; ++pass) {
    const int k = r + pass * 16;
    float4 v = make_float4(0.f, 0.f, 0.f, 0.f);
    if (valid) {
      const float* wp = src + (size_t)(k0 + k) * Nsrc + col;
      v.x = __builtin_nontemporal_load(wp); v.y = __builtin_nontemporal_load(wp + 1);
      v.z = __builtin_nontemporal_load(wp + 2); v.w = __builtin_nontemporal_load(wp + 3);
    }
    float* t = tile + k * 65 + c4 * 4;
    t[0] = v.x; t[1] = v.y; t[2] = v.z; t[3] = v.w;
  }
  __syncthreads();
  const int nn = tid >> 2, kp = tid & 3;
  const float* t = tile + (kp * 16) * 65 + nn;
  uint4 o0, o1;
  o0.x = pack2(t[0 * 65], t[1 * 65]); o0.y = pack2(t[2 * 65], t[3 * 65]);
  o0.z = pack2(t[4 * 65], t[5 * 65]); o0.w = pack2(t[6 * 65], t[7 * 65]);
  o1.x = pack2(t[8 * 65], t[9 * 65]); o1.y = pack2(t[10 * 65], t[11 * 65]);
  o1.z = pack2(t[12 * 65], t[13 * 65]); o1.w = pack2(t[14 * 65], t[15 * 65]);
  uint4* dst = (uint4*)(out + (size_t)(n0 + nn) * Kdim + k0 + kp * 16);
  dst[0] = o0; dst[1] = o1;
}

DI void phase0(const Params& p, unsigned char* smem) {
  unsigned char* ws = p.ws;
  float* tile = (float*)smem;
  constexpr int T0 = 16 * 34, T1 = 16 * 16, T2 = 16 * 88, T3 = 44 * 16, T4 = 16 * 96, T5 = 32 * 16, T6 = T2, T7 = T3;
  constexpr int S1 = T0, S2 = S1 + T1, S3 = S2 + T2, S4 = S3 + T3, S5 = S4 + T4, S6 = S5 + T5, S7 = S6 + T6, S8 = S7 + T7;
  constexpr int NMOD = 192, NSC1 = 256, NCACHE = 512;
  constexpr int E1 = S8 + NMOD, E2 = E1 + NSC1, E3 = E2 + NCACHE, E4 = E3 + 20;
  const int tid = threadIdx.x;
  for (int it = blockIdx.x; it < E4; it += p.gsz) {
    if (it < S8) {
      if (it < S1) { int i = it; wconv_tile(p.in[12], nullptr, 2, 1024, 2064, i / 34, i % 34, (bf16_t*)(ws + OFF_WIN0), tile); }
      else if (it < S2) { int i = it - S1; wconv_tile(p.in[13], nullptr, 0, 1024, 1024, i / 16, i % 16, (bf16_t*)(ws + OFF_WOUT0), tile); }
      else if (it < S3) { int i = it - S2; wconv_tile(p.in[22], p.in[23], 1, 1024, 2816, i / 88, i % 88, (bf16_t*)(ws + OFF_WGU0), tile); }
      else if (it < S4) { int i = it - S3; wconv_tile(p.in[24], nullptr, 0, 2816, 1024, i / 16, i % 16, (bf16_t*)(ws + OFF_WDN0), tile); }
      else if (it < S5) { int i = it - S4; wconv_tile(p.in[29], nullptr, 3, 1024, 6144, i / 96, i % 96, (bf16_t*)(ws + OFF_WIN1), tile); }
      else if (it < S6) { int i = it - S5; wconv_tile(p.in[30], nullptr, 0, 2048, 1024, i / 16, i % 16, (bf16_t*)(ws + OFF_WOUT1), tile); }
      else if (it < S7) { int i = it - S6; wconv_tile(p.in[33], p.in[34], 1, 1024, 2816, i / 88, i % 88, (bf16_t*)(ws + OFF_WGU1), tile); }
      else { int i = it - S7; wconv_tile(p.in[35], nullptr, 0, 2816, 1024, i / 16, i % 16, (bf16_t*)(ws + OFF_WDN1), tile); }
    } else if (it < E1) {
      const int i = it - S8, layer = i / 96, cgp = i % 96;
      const float* wada = p.in[layer ? 25 : 8];
      const float* bada = p.in[layer ? 26 : 9];
      float* scond = (float*)smem;
      float* red = scond + 3072;
      __syncthreads();
      for (int e = tid; e < 3072; e += 256) {
        const int r = e >> 10, k = e & 1023;
        const float cv = (r == 0) ? p.in[7][k] : p.in[2][(r - 1) * 1024 + k];
        scond[e] = siluf(cv);
      }
      __syncthreads();
      const int n = cgp * 64 + (tid & 63), kq = tid >> 6;
      float a0 = 0.f, a1 = 0.f, a2 = 0.f;
#pragma unroll 8
      for (int k = kq * 256; k < kq * 256 + 256; ++k) {
        const float wv = __builtin_nontemporal_load(wada + (size_t)k * 6144 + n);
        a0 += scond[k] * wv; a1 += scond[1024 + k] * wv; a2 += scond[2048 + k] * wv;
      }
      red[(kq * 3 + 0) * 64 + (tid & 63)] = a0;
      red[(kq * 3 + 1) * 64 + (tid & 63)] = a1;
      red[(kq * 3 + 2) * 64 + (tid & 63)] = a2;
      __syncthreads();
      if (tid < 192) {
        const int r = tid >> 6, c = tid & 63;
        const float s = red[(0 * 3 + r) * 64 + c] + red[(1 * 3 + r) * 64 + c] + red[(2 * 3 + r) * 64 + c] + red[(3 * 3 + r) * 64 + c];
        float* mod = (float*)(ws + OFF_MOD);
        mod[(layer * 3 + r) * 6144 + cgp * 64 + c] = s + bada[cgp * 64 + c];
      }
    } else if (it < E2) {
      const int e = (it - E1) * 256 + tid;
      const int tok = e >> 2, h = e & 3;
      const int il = tok & 255;
      const float lgf = -__expf(p.in[31][h]), lgb = -__expf(p.in[31][4 + h]);
      float* sc = (float*)(ws + OFF_SC1);
      const size_t NS = (size_t)NTOK * 4;
      sc[0 * NS + e] = __expf((il + 1) * lgf);
      sc[1 * NS + e] = __expf((256 - il) * lgb);
      sc[2 * NS + e] = __expf((255 - il) * lgf);
      sc[3 * NS + e] = __expf(il * lgb);
      sc[4 * NS + e] = (il + 1) * lgf;
      sc[5 * NS + e] = (256 - il) * lgb;
      sc[6 * NS + e] = 1.f;
      sc[7 * NS + e] = 1.f;
    } else if (it >= E3) {
      const int i = it - E3;
      float sn, cs;
      if (i < 4) {
        const int e = i * 256 + tid, pos = e >> 4, f = e & 15;
        sincos_rev((float)pos * exp2f(-(float)f * (13.287712379549449f / 16.f)), sn, cs);
        ((float2*)(ws + OFF_ROPE0))[e] = make_float2(cs, sn);
      } else {
        const int e = (i - 4) * 256 + tid, pos = e >> 6, f = e & 63;
        sincos_rev((float)pos * exp2f(-(float)f * (13.287712379549449f / 64.f)), sn, cs);
        ((float2*)(ws + OFF_ROPE1))[e] = make_float2(cs, sn);
      }
    } else {
      const int i = it - E2;
      const int isv = i >> 8;
      const int e = (i & 255) * 256 + tid;
      const int b = e >> 15, rem = e & 32767;
      const float v = p.in[isv ? 4 : 3][e];
      bf16_t* dst = (bf16_t*)(ws + (isv ? OFF_VL : OFF_KL));
      dst[(size_t)b * 4352 * 128 + rem] = f2bf(v);
    }
  }
}

DI void phase_normmod(const Params& p, const float* xsrc, const float* gain, int layer, int shift_idx, int scale_idx) {
  const int lane = threadIdx.x & 63, w = threadIdx.x >> 6;
  bf16_t* H = (bf16_t*)(p.ws + OFF_H);
  const float* mod = (const float*)(p.ws + OFF_MOD) + (size_t)layer * 3 * 6144;
  for (int tok = (blockIdx.x * 4 + w) * 2; tok < NTOK; tok += p.gsz * 8) {
    float4 v[2][4];
#pragma unroll
    for (int r = 0; r < 2; ++r) {
      const float* xr = xsrc ? xsrc + (size_t)(tok + r) * DM : xin_row(p, tok + r);
#pragma unroll
      for (int i = 0; i < 4; ++i) v[r][i] = *(const float4*)(xr + i * 256 + lane * 4);
    }
    const int cr = cond_row(tok);
    const float* sh = mod + cr * 6144 + shift_idx * 1024;
    const float* sc = mod + cr * 6144 + scale_idx * 1024;
    float rinv[2];
#pragma unroll
    for (int r = 0; r < 2; ++r) {
      float ss = 0.f;
#pragma unroll
      for (int i = 0; i < 4; ++i) ss += v[r][i].x * v[r][i].x + v[r][i].y * v[r][i].y + v[r][i].z * v[r][i].z + v[r][i].w * v[r][i].w;
      ss = wave_sum(ss);
      rinv[r] = rsqrtf(ss * (1.f / 1024.f) + EPSF);
    }
#pragma unroll
    for (int i = 0; i < 4; ++i) {
      const int col = i * 256 + lane * 4;
      const float4 g = *(const float4*)(gain + col);
      const float4 s1 = *(const float4*)(sc + col);
      const float4 s0 = *(const float4*)(sh + col);
#pragma unroll
      for (int r = 0; r < 2; ++r) {
        const float o0 = v[r][i].x * rinv[r] * g.x * (1.f + s1.x) + s0.x;
        const float o1 = v[r][i].y * rinv[r] * g.y * (1.f + s1.y) + s0.y;
        const float o2 = v[r][i].z * rinv[r] * g.z * (1.f + s1.z) + s0.z;
        const float o3 = v[r][i].w * rinv[r] * g.w * (1.f + s1.w) + s0.w;
        uint2 pk; pk.x = pack2(o0, o1); pk.y = pack2(o2, o3);
        *(uint2*)(H + (size_t)(tok + r) * DM + col) = pk;
      }
    }
  }
}

DI void phase_l0_inproj(const Params& p, unsigned char* smem) {
  unsigned char* ws = p.ws;
  bf16_t* lA = (bf16_t*)smem; bf16_t* lB = lA + 128 * LDK;
  const bf16_t* H = (const bf16_t*)(ws + OFF_H);
  const bf16_t* W = (const bf16_t*)(ws + OFF_WIN0);
  const int lane = threadIdx.x & 63, w = threadIdx.x >> 6, wm = w >> 1, wn = w & 1;
  const int c = lane & 15;
  bf16_t* Q0 = (bf16_t*)(ws + OFF_Q0);
  bf16_t* Kc = (bf16_t*)(ws + OFF_KC); bf16_t* Vc = (bf16_t*)(ws + OFF_VC);
  bf16_t* Kl = (bf16_t*)(ws + OFF_KL); bf16_t* Vl = (bf16_t*)(ws + OFF_VL);
  bf16_t* Zs = (bf16_t*)(ws + OFF_ZS);
  float* XBC = (float*)(ws + OFF_XBC); float* DT = (float*)(ws + OFF_DT);
  const float2* rope0 = (const float2*)(ws + OFF_ROPE0);
  for (int it = blockIdx.x; it < 128 * 17; it += p.gsz) {
    const int tl_ = xcd_tile(it, 128 * 17); const int rt = tl_ / 17, ct = tl_ % 17;
    f32x4 acc[4][4];
    zero_acc(acc);
    gemm_seg<false, false>(H + (size_t)rt * 128 * DM, DM, nullptr, 0, 128, W + (size_t)ct * 128 * DM, DM, nullptr, 0, 128, DM, acc, lA, lB);
    const int row0 = rt * 128 + wm * 64, col0 = ct * 128 + wn * 64;
    if (col0 < 640) {
      const bool isq = col0 < 512;
      const int head = isq ? (col0 >> 6) : ((col0 - 512) >> 6);
      const float* gain = p.in[isq ? 14 : 15];
      const float g0 = gain[c], g1 = gain[32 + c], g2 = gain[16 + c], g3 = gain[48 + c];
#pragma unroll
      for (int tm = 0; tm < 4; ++tm)
#pragma unroll
        for (int j = 0; j < 4; ++j) {
          const int tok = row0 + tm * 16 + (lane >> 4) * 4 + j;
          float v0 = acc[tm][0][j], v1 = acc[tm][1][j], v2 = acc[tm][2][j], v3 = acc[tm][3][j];
          float ss = v0 * v0 + v1 * v1 + v2 * v2 + v3 * v3;
          ss = sum16(ss);
          const float rinv = rsqrtf(ss * (1.f / 64.f) + EPSF);
          v0 *= rinv * g0; v1 *= rinv * g1; v2 *= rinv * g2; v3 *= rinv * g3;
          if (tok < NCTX) {
            if (isq) {
              bf16_t* d = Q0 + (size_t)tok * 512 + head * 64;
              d[c] = f2bf(v0); d[32 + c] = f2bf(v1); d[16 + c] = f2bf(v2); d[48 + c] = f2bf(v3);
            } else {
              float* o = p.out + OUT_K0 + (size_t)tok * 128 + head * 64;
              o[c] = v0; o[32 + c] = v1; o[16 + c] = v2; o[48 + c] = v3;
              bf16_t* d = Kc + (size_t)tok * 128 + head * 64;
              d[c] = f2bf(v0); d[32 + c] = f2bf(v1); d[16 + c] = f2bf(v2); d[48 + c] = f2bf(v3);
            }
          } else {
            const int u = tok - NCTX, tl = u & 4095, b = u >> 12;
            const float2 t0 = rope0[(tl >> 6) * 16 + c], t1 = rope0[(tl & 63) * 16 + c];
            const float c0 = t0.x, s0 = t0.y, c1 = t1.x, s1 = t1.y;
            const float a0 = v0 * c0 - v1 * s0, a1 = v1 * c0 + v0 * s0;
            const float a2 = v2 * c1 - v3 * s1, a3 = v3 * c1 + v2 * s1;
            bf16_t* d = isq ? (Q0 + (size_t)tok * 512 + head * 64)
                            : (Kl + ((size_t)b * 4352 + 256 + tl) * 128 + head * 64);
            d[c] = f2bf(a0); d[32 + c] = f2bf(a1); d[16 + c] = f2bf(a2); d[48 + c] = f2bf(a3);
          }
        }
    } else if (col0 < 768) {
      const int kv = (col0 - 640) >> 6;
#pragma unroll
      for (int tm = 0; tm < 4; ++tm)
#pragma unroll
        for (int j = 0; j < 4; ++j) {
          const int tok = row0 + tm * 16 + (lane >> 4) * 4 + j;
#pragma unroll
          for (int tn = 0; tn < 4; ++tn) {
            const float v = acc[tm][tn][j];
            const int o = kv * 64 + tn * 16 + c;
            if (tok < NCTX) {
              p.out[OUT_V0 + (size_t)tok * 128 + o] = v;
              Vc[(size_t)tok * 128 + o] = f2bf(v);
            } else {
              const int u = tok - NCTX, tl = u & 4095, b = u >> 12;
              Vl[((size_t)b * 4352 + 256 + tl) * 128 + o] = f2bf(v);
            }
          }
        }
    } else if (col0 < 1280) {
#pragma unroll
      for (int tm = 0; tm < 4; ++tm)
#pragma unroll
        for (int j = 0; j < 4; ++j) {
          const int tok = row0 + tm * 16 + (lane >> 4) * 4 + j;
#pragma unroll
          for (int tn = 0; tn < 4; ++tn)
            Zs[(size_t)tok * 512 + (col0 - 768) + tn * 16 + c] = f2bf(siluf(acc[tm][tn][j]));
        }
    } else if (col0 < 2048) {
#pragma unroll
      for (int tm = 0; tm < 4; ++tm)
#pragma unroll
        for (int j = 0; j < 4; ++j) {
          const int tok = row0 + tm * 16 + (lane >> 4) * 4 + j;
#pragma unroll
          for (int tn = 0; tn < 4; ++tn)
            XBC[(size_t)tok * 768 + (col0 - 1280) + tn * 16 + c] = acc[tm][tn][j];
        }
    } else if (col0 == 2048) {
#pragma unroll
      for (int tm = 0; tm < 4; ++tm)
#pragma unroll
        for (int j = 0; j < 4; ++j) {
          const int tok = row0 + tm * 16 + (lane >> 4) * 4 + j;
          DT[(size_t)tok * 16 + c] = acc[tm][0][j];
        }
    }
  }
}

constexpr int ALD = 72;
DI void attn_item(const Params& p, int item, unsigned char* smem) {
  unsigned char* ws = p.ws;
  bf16_t* sK = (bf16_t*)smem;
  bf16_t* sVt = sK + 64 * ALD;
  bf16_t* sP = sVt + 64 * ALD;
  const int tid = threadIdx.x, lane = tid & 63, w = tid >> 6;
  int b, hq, qb, tok0, nkeys;
  const bf16_t *Kb, *Vb;
  if (item < 512) {
    qb = item & 31; hq = (item >> 5) & 7; b = item >> 8;
    tok0 = NCTX + b * 4096 + qb * 128; nkeys = 4352;
    Kb = (const bf16_t*)(ws + OFF_KL) + (size_t)b * 4352 * 128;
    Vb = (const bf16_t*)(ws + OFF_VL) + (size_t)b * 4352 * 128;
  } else {
    const int i = item - 512;
    qb = i & 1; hq = (i >> 1) & 7; b = i >> 4;
    tok0 = b * 256 + qb * 128; nkeys = 256;
    Kb = (const bf16_t*)(ws + OFF_KC) + (size_t)b * 256 * 128;
    Vb = (const bf16_t*)(ws + OFF_VC) + (size_t)b * 256 * 128;
  }
  const int kv = hq >> 2;
  Kb += kv * 64; Vb += kv * 64;
  const bf16_t* Q0 = (const bf16_t*)(ws + OFF_Q0);
  const int g4 = lane >> 4, ln = lane & 15;
  bf16x8 qf[2][2];
#pragma unroll
  for (int qb = 0; qb < 2; ++qb)
#pragma unroll
    for (int ks = 0; ks < 2; ++ks)
      qf[qb][ks] = *(const bf16x8*)(Q0 + (size_t)(tok0 + w * 32 + qb * 16 + ln) * 512 + hq * 64 + ks * 32 + g4 * 8);
  f32x4 O[4][2];
  float m[2], l[2];
#pragma unroll
  for (int qb = 0; qb < 2; ++qb) {
#pragma unroll
    for (int d = 0; d < 4; ++d) O[d][qb] = f32x4{0.f, 0.f, 0.f, 0.f};
    m[qb] = -1e30f; l[qb] = 0.f;
  }
  const int nt = nkeys >> 6;
  const int key0 = tid >> 3, key1 = (tid + 256) >> 3, dc0 = tid & 7;
  uint4 rk0 = *(const uint4*)(Kb + (size_t)key0 * 128 + dc0 * 8);
  uint4 rk1 = *(const uint4*)(Kb + (size_t)key1 * 128 + dc0 * 8);
  const int vkey = tid & 63, vdc0 = tid >> 6, vdc1 = vdc0 + 4;
  uint4 rv0 = *(const uint4*)(Vb + (size_t)vkey * 128 + vdc0 * 8);
  uint4 rv1 = *(const uint4*)(Vb + (size_t)vkey * 128 + vdc1 * 8);
  for (int kt = 0; kt < nt; ++kt) {
    __syncthreads();
    *(uint4*)(sK + key0 * ALD + dc0 * 8) = rk0;
    *(uint4*)(sK + key1 * ALD + dc0 * 8) = rk1;
    {
      bf16_t* q = sVt + (vdc0 * 8) * ALD + vkey;
      q[0 * ALD] = (bf16_t)(rv0.x & 0xffffu); q[1 * ALD] = (bf16_t)(rv0.x >> 16);
      q[2 * ALD] = (bf16_t)(rv0.y & 0xffffu); q[3 * ALD] = (bf16_t)(rv0.y >> 16);
      q[4 * ALD] = (bf16_t)(rv0.z & 0xffffu); q[5 * ALD] = (bf16_t)(rv0.z >> 16);
      q[6 * ALD] = (bf16_t)(rv0.w & 0xffffu); q[7 * ALD] = (bf16_t)(rv0.w >> 16);
      q = sVt + (vdc1 * 8) * ALD + vkey;
      q[0 * ALD] = (bf16_t)(rv1.x & 0xffffu); q[1 * ALD] = (bf16_t)(rv1.x >> 16);
      q[2 * ALD] = (bf16_t)(rv1.y & 0xffffu); q[3 * ALD] = (bf16_t)(rv1.y >> 16);
      q[4 * ALD] = (bf16_t)(rv1.z & 0xffffu); q[5 * ALD] = (bf16_t)(rv1.z >> 16);
      q[6 * ALD] = (bf16_t)(rv1.w & 0xffffu); q[7 * ALD] = (bf16_t)(rv1.w >> 16);
    }
    __syncthreads();
    if (kt + 1 < nt) {
      const size_t kbase = (size_t)(kt + 1) * 64;
      rk0 = *(const uint4*)(Kb + (kbase + key0) * 128 + dc0 * 8);
      rk1 = *(const uint4*)(Kb + (kbase + key1) * 128 + dc0 * 8);
      rv0 = *(const uint4*)(Vb + (kbase + vkey) * 128 + vdc0 * 8);
      rv1 = *(const uint4*)(Vb + (kbase + vkey) * 128 + vdc1 * 8);
    }
    f32x4 s[4][2];
    __builtin_amdgcn_s_setprio(1);
#pragma unroll
    for (int kb = 0; kb < 4; ++kb) {
      const bf16x8 k0 = *(const bf16x8*)(sK + (kb * 16 + ln) * ALD + g4 * 8);
      const bf16x8 k1 = *(const bf16x8*)(sK + (kb * 16 + ln) * ALD + 32 + g4 * 8);
#pragma unroll
      for (int qb = 0; qb < 2; ++qb) {
        f32x4 z = f32x4{0.f, 0.f, 0.f, 0.f};
        z = __builtin_amdgcn_mfma_f32_16x16x32_bf16(k0, qf[qb][0], z, 0, 0, 0);
        z = __builtin_amdgcn_mfma_f32_16x16x32_bf16(k1, qf[qb][1], z, 0, 0, 0);
        s[kb][qb] = z;
      }
    }
    __builtin_amdgcn_s_setprio(0);
#pragma unroll
    for (int qb = 0; qb < 2; ++qb) {
      float mx = -1e30f;
#pragma unroll
      for (int kb = 0; kb < 4; ++kb)
        mx = fmaxf(mx, fmaxf(fmaxf(s[kb][qb][0], s[kb][qb][1]), fmaxf(s[kb][qb][2], s[kb][qb][3])));
      mx *= 0.18033688011112042f;
      mx = fmaxf(mx, __shfl_xor(mx, 16, 64));
      mx = fmaxf(mx, __shfl_xor(mx, 32, 64));
      const float mn = fmaxf(m[qb], mx);
      const float alpha = __builtin_amdgcn_exp2f(m[qb] - mn);
      m[qb] = mn;
      float rs = 0.f;
#pragma unroll
      for (int kb = 0; kb < 4; ++kb)
#pragma unroll
        for (int j = 0; j < 4; ++j) {
          const float pv = __builtin_amdgcn_exp2f(s[kb][qb][j] * 0.18033688011112042f - mn);
          rs += pv;
          s[kb][qb][j] = pv;
        }
      l[qb] = l[qb] * alpha + rs;
#pragma unroll
      for (int d = 0; d < 4; ++d) {
        O[d][qb][0] *= alpha; O[d][qb][1] *= alpha; O[d][qb][2] *= alpha; O[d][qb][3] *= alpha;
      }
    }
    __builtin_amdgcn_s_setprio(1);
#pragma unroll
    for (int ksp = 0; ksp < 2; ++ksp) {
      bf16x8 pb[2];
#pragma unroll
      for (int qb = 0; qb < 2; ++qb) {
        uint4 u;
        u.x = pack2(s[2 * ksp][qb][0], s[2 * ksp][qb][1]); u.y = pack2(s[2 * ksp][qb][2], s[2 * ksp][qb][3]);
        u.z = pack2(s[2 * ksp + 1][qb][0], s[2 * ksp + 1][qb][1]); u.w = pack2(s[2 * ksp + 1][qb][2], s[2 * ksp + 1][qb][3]);
        pb[qb] = __builtin_bit_cast(bf16x8, u);
      }
#pragma unroll
      for (int d = 0; d < 4; ++d) {
        const bf16_t* vp = sVt + (d * 16 + ln) * ALD + 32 * ksp + 4 * g4;
        uint4 u;
        const uint2 lo = *(const uint2*)vp, hi = *(const uint2*)(vp + 16);
        u.x = lo.x; u.y = lo.y; u.z = hi.x; u.w = hi.y;
        const bf16x8 va = __builtin_bit_cast(bf16x8, u);
#pragma unroll
        for (int qb = 0; qb < 2; ++qb)
          O[d][qb] = __builtin_amdgcn_mfma_f32_16x16x32_bf16(va, pb[qb], O[d][qb], 0, 0, 0);
      }
    }
    __builtin_amdgcn_s_setprio(0);
  }
  bf16_t* Aout = (bf16_t*)(ws + OFF_AOUT);
#pragma unroll
  for (int qb = 0; qb < 2; ++qb) {
    float lt = l[qb];
    lt += __shfl_xor(lt, 16, 64);
    lt += __shfl_xor(lt, 32, 64);
    const float inv = 1.f / lt;
    const int tok = tok0 + w * 32 + qb * 16 + ln;
#pragma unroll
    for (int d = 0; d < 4; ++d) {
      uint2 pk;
      pk.x = pack2(O[d][qb][0] * inv, O[d][qb][1] * inv);
      pk.y = pack2(O[d][qb][2] * inv, O[d][qb][3] * inv);
      *(uint2*)(Aout + (size_t)tok * DM + hq * 64 + d * 16 + g4 * 4) = pk;
    }
  }
}

template <class F>
DI void conv_run(const float* XBC, const float* cw, const float* cbias, int col, int tbeg, int seq_lo, int seq_hi, F&& emit) {
  const float w0 = cw[0 * 768 + col], w1 = cw[1 * 768 + col], w2 = cw[2 * 768 + col], w3 = cw[3 * 768 + col], w4 = cw[4 * 768 + col];
  const float bias = cbias[col];
  float xm2 = (tbeg - 2 >= seq_lo) ? XBC[(size_t)(tbeg - 2) * 768 + col] : 0.f;
  float xm1 = (tbeg - 1 >= seq_lo) ? XBC[(size_t)(tbeg - 1) * 768 + col] : 0.f;
  float x0 = XBC[(size_t)tbeg * 768 + col];
  float xp1 = (tbeg + 1 < seq_hi) ? XBC[(size_t)(tbeg + 1) * 768 + col] : 0.f;
#pragma unroll 1
  for (int t16 = 0; t16 < 64; t16 += 16) {
    float xn[16];
#pragma unroll
    for (int i = 0; i < 16; ++i) {
      const int tk = tbeg + t16 + i + 2;
      xn[i] = (tk < seq_hi) ? XBC[(size_t)tk * 768 + col] : 0.f;
    }
#pragma unroll
    for (int hf = 0; hf < 2; ++hf) {
      float y[8];
#pragma unroll
      for (int i = 0; i < 8; ++i) {
        y[i] = siluf(bias + xm2 * w0 + xm1 * w1 + x0 * w2 + xp1 * w3 + xn[hf * 8 + i] * w4);
        xm2 = xm1; xm1 = x0; x0 = xp1; xp1 = xn[hf * 8 + i];
      }
      emit(tbeg + t16 + hf * 8, y);
    }
  }
}
DI uint4 pack8(const float (&y)[8]) {
  uint4 u; u.x = pack2(y[0], y[1]); u.y = pack2(y[2], y[3]); u.z = pack2(y[4], y[5]); u.w = pack2(y[6], y[7]);
  return u;
}

DI void ssd_prep_item(const Params& p, int item, unsigned char* smem) {
  unsigned char* ws = p.ws;
  const int tid = threadIdx.x;
  const int c = item / 10, u = item % 10, tok0 = c * 256;
  int seq_lo, seq_hi;
  if (c < 32) { seq_lo = tok0; seq_hi = tok0 + 256; }
  else { const int b = (c - 32) >> 4; seq_lo = NCTX + b * 4096; seq_hi = seq_lo + 4096; }
  const float* XBC = (const float*)(ws + OFF_XBC);
  const float* cw = p.in[16];
  const float* cbias = p.in[17];
  const int chl = tid & 63, tg = tid >> 6;
  const int tbeg = tok0 + tg * 64;
  if (u < 8) {
    const int h = u, g = h >> 2;
    float* sf = (float*)smem;
    float* sb = sf + 256;
    const float* DT = (const float*)(ws + OFF_DT);
    float dtv[2], av[2];
#pragma unroll
    for (int dir = 0; dir < 2; ++dir) {
      const float raw = DT[(size_t)(tok0 + tid) * 16 + dir * 8 + h] + p.in[18][dir * 8 + h];
      const float sp = fmaxf(raw, 0.f) + log1pf(__expf(-fabsf(raw)));
      dtv[dir] = sp;
      av[dir] = -sp * __expf(p.in[19][dir * 8 + h]);
    }
    __syncthreads();
    sf[tid] = av[0]; sb[tid] = av[1];
    __syncthreads();
    for (int off = 1; off < 256; off <<= 1) {
      const float vf = sf[tid] + (tid >= off ? sf[tid - off] : 0.f);
      const float vb = sb[tid] + (tid + off < 256 ? sb[tid + off] : 0.f);
      __syncthreads();
      sf[tid] = vf; sb[tid] = vb;
      __syncthreads();
    }
    const float cf = sf[tid], cb = sb[tid], totf = sf[255], totb = sb[0];
    float* sc = (float*)(ws + OFF_SC0);
    const size_t NS = (size_t)NTOK * 8;
    const size_t e = (size_t)(tok0 + tid) * 8 + h;
    const float wfv = dtv[0] * __expf(totf - cf), wbv = dtv[1] * __expf(totb - cb);
    sc[0 * NS + e] = __expf(cf);
    sc[1 * NS + e] = __expf(cb);
    sc[4 * NS + e] = cf;
    sc[5 * NS + e] = cb;
    sc[6 * NS + e] = dtv[0];
    sc[7 * NS + e] = dtv[1];
    __syncthreads();
    sf[tid] = wfv; sb[tid] = wbv;
    __syncthreads();
    {
      const int col = h * 64 + chl;
      float* XS = (float*)(ws + OFF_XS);
      bf16_t* VT = (bf16_t*)(ws + OFF_VS);
      conv_run(XBC, cw, cbias, col, tbeg, seq_lo, seq_hi, [&](int t, const float (&y)[8]) {
#pragma unroll
        for (int i = 0; i < 8; ++i) XS[(size_t)(t + i) * 512 + col] = y[i];
        *(uint4*)(VT + ((size_t)c * 512 + col) * 256 + (t - tok0)) = pack8(y);
      });
    }
    {
      const int col = 512 + g * 64 + chl;
      bf16_t* KT = (bf16_t*)(ws + OFF_SST1B);
      bf16_t* ktf = KT + ((size_t)((c * 2 + 0) * 8 + h) * 64 + chl) * 256;
      bf16_t* ktb = KT + ((size_t)((c * 2 + 1) * 8 + h) * 64 + chl) * 256;
      conv_run(XBC, cw, cbias, col, tbeg, seq_lo, seq_hi, [&](int t, const float (&y)[8]) {
        const int tl = t - tok0;
        float yf[8], yb[8];
#pragma unroll
        for (int i = 0; i < 8; ++i) { yf[i] = y[i] * sf[tl + i]; yb[i] = y[i] * sb[tl + i]; }
        *(uint4*)(ktf + tl) = pack8(yf);
        *(uint4*)(ktb + tl) = pack8(yb);
      });
    }
  } else {
    const int g = u - 8;
    bf16_t* BBp = (bf16_t*)(ws + OFF_BB);
    bf16_t* CCp = (bf16_t*)(ws + OFF_CC);
    conv_run(XBC, cw, cbias, 512 + g * 64 + chl, tbeg, seq_lo, seq_hi, [&](int t, const float (&y)[8]) {
#pragma unroll
      for (int i = 0; i < 8; ++i) BBp[(size_t)(t + i) * 128 + g * 64 + chl] = f2bf(y[i]);
    });
    conv_run(XBC, cw, cbias, 640 + g * 64 + chl, tbeg, seq_lo, seq_hi, [&](int t, const float (&y)[8]) {
#pragma unroll
      for (int i = 0; i < 8; ++i) CCp[(size_t)(t + i) * 128 + g * 64 + chl] = f2bf(y[i]);
    });
  }
}

DI void pgemm_tile(const bf16_t* Q, int ldq, const bf16_t* Kp, int ldk, int dk, const float* sc, int H, int h, int tok0,
                   int ti, int tj, bf16_t* Pout, unsigned char* smem) {
  bf16_t* lA = (bf16_t*)smem; bf16_t* lB = lA + 128 * LDK;
  const int lane = threadIdx.x & 63, w = threadIdx.x >> 6, wm = w >> 1, wn = w & 1;
  f32x4 acc[4][4];
  zero_acc(acc);
  gemm_seg<false, false>(Q + (size_t)(ti * 128) * ldq, ldq, nullptr, 0, 128, Kp + (size_t)(tj * 128) * ldk, ldk, nullptr, 0, 128, dk, acc, lA, lB);
  const size_t NS = (size_t)NTOK * H;
  const float* CUMF = sc + 4 * NS; const float* CUMB = sc + 5 * NS; const float* DTF = sc + 6 * NS; const float* DTB = sc + 7 * NS;
  float cfj[4], cbj[4], dfj[4], dbj[4];
#pragma unroll
  for (int tn = 0; tn < 4; ++tn) {
    const int jj = tj * 128 + wn * 64 + tn * 16 + (lane & 15);
    const size_t e = (size_t)(tok0 + jj) * H + h;
    cfj[tn] = CUMF[e]; cbj[tn] = CUMB[e]; dfj[tn] = DTF[e]; dbj[tn] = DTB[e];
  }
#pragma unroll
  for (int tm = 0; tm < 4; ++tm)
#pragma unroll
    for (int j = 0; j < 4; ++j) {
      const int i = ti * 128 + wm * 64 + tm * 16 + (lane >> 4) * 4 + j;
      const size_t e = (size_t)(tok0 + i) * H + h;
      const float cfi = CUMF[e], cbi = CUMB[e];
#pragma unroll
      for (int tn = 0; tn < 4; ++tn) {
        const int jj = tj * 128 + wn * 64 + tn * 16 + (lane & 15);
        float mk = 0.f;
        if (jj <= i) mk += __expf(cfi - cfj[tn]) * dfj[tn];
        if (jj >= i) mk += __expf(cbi - cbj[tn]) * dbj[tn];
        Pout[(size_t)i * 256 + jj] = f2bf(acc[tm][tn][j] * mk);
      }
    }
}

DI void dsgemm_tile(const bf16_t* Kp, int ldk, const float* wsc, int ss, const bf16_t* V, int ldv, int dk, int dv,
                    int tmi, int tni, float* out, unsigned char* smem) {
  bf16_t* lA = (bf16_t*)smem; bf16_t* lB = lA + 128 * LDK;
  const int lane = threadIdx.x & 63, w = threadIdx.x >> 6, wm = w >> 1, wn = w & 1;
  f32x4 acc[4][4];
  zero_acc(acc);
  const int Mlim = dk - tmi * 128 < 128 ? dk - tmi * 128 : 128;
  const int Nlim = dv - tni * 128 < 128 ? dv - tni * 128 : 128;
  gemm_seg<true, true>(Kp + tmi * 128, ldk, wsc, ss, Mlim, V + tni * 128, ldv, nullptr, 0, Nlim, 256, acc, lA, lB);
#pragma unroll
  for (int tm = 0; tm < 4; ++tm)
#pragma unroll
    for (int j = 0; j < 4; ++j) {
      const int d = tmi * 128 + wm * 64 + tm * 16 + (lane >> 4) * 4 + j;
#pragma unroll
      for (int tn = 0; tn < 4; ++tn) {
        const int e = tni * 128 + wn * 64 + tn * 16 + (lane & 15);
        if (d < dk && e < dv) out[(size_t)d * dv + e] = acc[tm][tn][j];
      }
    }
}

DI void dsgemm_nt_tile(const bf16_t* A, const bf16_t* B, int tmi, int tni, float* out, bf16_t* outb, int ldo, unsigned char* smem) {
  bf16_t* lA = (bf16_t*)smem; bf16_t* lB = lA + 128 * LDK;
  const int lane = threadIdx.x & 63, w = threadIdx.x >> 6, wm = w >> 1, wn = w & 1;
  f32x4 acc[4][4];
  zero_acc(acc);
  gemm_seg<false, false>(A + (size_t)tmi * 128 * 256, 256, nullptr, 0, 128, B + (size_t)tni * 128 * 256, 256, nullptr, 0, 128, 256, acc, lA, lB);
#pragma unroll
  for (int tm = 0; tm < 4; ++tm)
#pragma unroll
    for (int j = 0; j < 4; ++j) {
      const int r = tmi * 128 + wm * 64 + tm * 16 + (lane >> 4) * 4 + j;
#pragma unroll
      for (int tn = 0; tn < 4; ++tn) {
        const size_t o = (size_t)r * ldo + tni * 128 + wn * 64 + tn * 16 + (lane & 15);
        if (out) __builtin_nontemporal_store(acc[tm][tn][j], out + o);
        else outb[o] = f2bf(acc[tm][tn][j]);
      }
    }
}

DI void phase_ssd_pds(const Params& p, unsigned char* smem) {
  unsigned char* ws = p.ws;
  const bf16_t* CC = (const bf16_t*)(ws + OFF_CC);
  const bf16_t* BB = (const bf16_t*)(ws + OFF_BB);
  const bf16_t* VsT = (const bf16_t*)(ws + OFF_VS);
  const bf16_t* KT0 = (const bf16_t*)(ws + OFF_SST1B);
  const float* sc = (const float*)(ws + OFF_SC0);
  for (int it = blockIdx.x; it < 2048; it += p.gsz) {
    const int c = it >> 5, h = (it >> 2) & 7, ti = (it >> 1) & 1, tj = it & 1, g = h >> 2, tok0 = c * 256;
    pgemm_tile(CC + (size_t)tok0 * 128 + g * 64, 128, BB + (size_t)tok0 * 128 + g * 64, 128, 64, sc, 8, h, tok0, ti, tj,
               (bf16_t*)(ws + OFF_P0) + (size_t)(c * 8 + h) * 65536, smem);
  }
#pragma unroll 1
  for (int i = blockIdx.x; i < 1024; i += p.gsz) {
    const int c = i >> 4, h = (i >> 1) & 7, dir = i & 1;
    bf16_t* lA = (bf16_t*)smem; bf16_t* lB = lA + 128 * LDK;
    const int lane = threadIdx.x & 63, w = threadIdx.x >> 6;
    f32x4 acc[4][4];
    zero_acc(acc);
    gemm_seg<false, false>(VsT + ((size_t)c * 512 + h * 64) * 256, 256, nullptr, 0, 64,
                           KT0 + ((size_t)((c * 2 + dir) * 8 + h) * 64) * 256, 256, nullptr, 0, 64, 256, acc, lA, lB);
    if (w == 0) {
      float* out = (float*)(ws + OFF_DS0) + (size_t)((c * 8 + h) * 2 + dir) * 4096;
#pragma unroll
      for (int tm = 0; tm < 4; ++tm)
#pragma unroll
        for (int j = 0; j < 4; ++j)
#pragma unroll
          for (int tn = 0; tn < 4; ++tn)
            out[(tm * 16 + (lane >> 4) * 4 + j) * 64 + tn * 16 + (lane & 15)] = acc[tm][tn][j];
    }
  }
}

DI void phase_ssd_scan(const Params& p) {
  unsigned char* ws = p.ws;
  const float* sc = (const float*)(ws + OFF_SC0);
  const size_t NS = (size_t)NTOK * 8;
  const float* CUMF = sc + 4 * NS; const float* CUMB = sc + 5 * NS;
  const float* DS = (const float*)(ws + OFF_DS0);
  bf16_t* SST = (bf16_t*)(ws + OFF_SST0);
  for (int idx = blockIdx.x * 256 + threadIdx.x; idx < 32 * 8 * 2 * 4096; idx += p.gsz * 256) {
    const int e = idx & 4095, dir = (idx >> 12) & 1, h = (idx >> 13) & 7, c = idx >> 16;
    p.out[OUT_SSD + (size_t)((c * 2 + dir) * 8 + h) * 4096 + e] = DS[(size_t)((c * 8 + h) * 2 + dir) * 4096 + (e & 63) * 64 + (e >> 6)];
  }
  for (int idx = blockIdx.x * 256 + threadIdx.x; idx < 131072; idx += p.gsz * 256) {
    const int e = idx & 4095, dir = (idx >> 12) & 1, h = (idx >> 13) & 7, b = idx >> 16;
    float S = p.in[5][(size_t)((b * 2 + dir) * 8 + h) * 4096 + (e & 63) * 64 + (e >> 6)];
    for (int s = 0; s < 16; ++s) {
      const int lc = dir ? 15 - s : s;
      const int c = 32 + b * 16 + lc;
      const size_t o = (size_t)((c * 8 + h) * 2 + dir) * 4096 + e;
      SST[o] = f2bf(S);
      const float tot = dir ? CUMB[(size_t)(c * 256) * 8 + h] : CUMF[(size_t)(c * 256 + 255) * 8 + h];
      S = __expf(tot) * S + DS[o];
    }
  }
}

DI void phase_ssd_y(const Params& p, unsigned char* smem) {
  unsigned char* ws = p.ws;
  bf16_t* lA = (bf16_t*)smem; bf16_t* lB = lA + 128 * LDK;
  const int lane = threadIdx.x & 63, w = threadIdx.x >> 6, wm = w >> 1, wn = w & 1;
  const bf16_t* CC = (const bf16_t*)(ws + OFF_CC);
  const bf16_t* VsT = (const bf16_t*)(ws + OFF_VS);
  const bf16_t* P0 = (const bf16_t*)(ws + OFF_P0);
  const bf16_t* SST = (const bf16_t*)(ws + OFF_SST0);
  const float* sc = (const float*)(ws + OFF_SC0);
  const size_t NS = (size_t)NTOK * 8;
  const float* XS = (const float*)(ws + OFF_XS);
  const bf16_t* Zs = (const bf16_t*)(ws + OFF_ZS);
  float* YG = (float*)(ws + OFF_YG);
  for (int it = blockIdx.x; it < 1024; it += p.gsz) {
    const int c = it >> 4, h = (it >> 1) & 7, ti = it & 1, g = h >> 2, tok0 = c * 256;
    f32x4 acc[4][4];
    zero_acc(acc);
    gemm_seg<false, false>(P0 + ((size_t)(c * 8 + h) * 256 + ti * 128) * 256, 256, nullptr, 0, 128,
                           VsT + ((size_t)c * 512 + h * 64) * 256, 256, nullptr, 0, 64, 256, acc, lA, lB);
    if (c >= 32) {
#pragma unroll 1
      for (int dir = 0; dir < 2; ++dir)
        gemm_seg<false, false>(CC + (size_t)(tok0 + ti * 128) * 128 + g * 64, 128, sc + dir * NS + (size_t)(tok0 + ti * 128) * 8 + h, 8, 128,
                               SST + (size_t)((c * 8 + h) * 2 + dir) * 4096, 64, nullptr, 0, 64, 64, acc, lA, lB);
    }
    if (wn == 0) {
      const float dsk = p.in[20][h];
#pragma unroll
      for (int tm = 0; tm < 4; ++tm)
#pragma unroll
        for (int j = 0; j < 4; ++j) {
          const int tok = tok0 + ti * 128 + wm * 64 + tm * 16 + (lane >> 4) * 4 + j;
#pragma unroll
          for (int tn = 0; tn < 4; ++tn) {
            const size_t o = (size_t)tok * 512 + h * 64 + tn * 16 + (lane & 15);
            const float y = acc[tm][tn][j] + dsk * XS[o];
            YG[o] = y * bf2f(Zs[o]);
          }
        }
    }
  }
}

DI void phase_ssd_norm(const Params& p) {
  unsigned char* ws = p.ws;
  const int lane = threadIdx.x & 63, w = threadIdx.x >> 6;
  const float* YG = (const float*)(ws + OFF_YG);
  bf16_t* Aout = (bf16_t*)(ws + OFF_AOUT);
  const float* gain = p.in[21];
  for (int tok = (blockIdx.x * 4 + w) * 2; tok < NTOK; tok += p.gsz * 8) {
    float4 v[2][2];
#pragma unroll
    for (int r = 0; r < 2; ++r)
#pragma unroll
      for (int i = 0; i < 2; ++i) v[r][i] = *(const float4*)(YG + (size_t)(tok + r) * 512 + i * 256 + lane * 4);
#pragma unroll
    for (int r = 0; r < 2; ++r) {
      float ss = 0.f;
#pragma unroll
      for (int i = 0; i < 2; ++i) ss += v[r][i].x * v[r][i].x + v[r][i].y * v[r][i].y + v[r][i].z * v[r][i].z + v[r][i].w * v[r][i].w;
      ss = wave_sum(ss);
      const float rinv = rsqrtf(ss * (1.f / 512.f) + EPSF);
#pragma unroll
      for (int i = 0; i < 2; ++i) {
        const int col = i * 256 + lane * 4;
        const float4 g = *(const float4*)(gain + col);
        uint2 pk;
        pk.x = pack2(v[r][i].x * rinv * g.x, v[r][i].y * rinv * g.y);
        pk.y = pack2(v[r][i].z * rinv * g.z, v[r][i].w * rinv * g.w);
        *(uint2*)(Aout + (size_t)(tok + r) * DM + 512 + col) = pk;
      }
    }
  }
}

DI void phase_res_gemm(const Params& p, const bf16_t* A, int lda, int K, const bf16_t* W, const float* xsrc, int layer, int gate_idx, unsigned char* smem) {
  unsigned char* ws = p.ws;
  bf16_t* lA = (bf16_t*)smem; bf16_t* lB = lA + 256 * LDK2;
  const int lane = threadIdx.x & 63, w = threadIdx.x >> 6, wm = w >> 1, wn = w & 1;
  float* X = (float*)(ws + OFF_X);
  const float* mod = (const float*)(ws + OFF_MOD) + (size_t)layer * 3 * 6144 + gate_idx * 1024;
  for (int it = blockIdx.x; it < 64 * 8; it += p.gsz) {
    const int tl_ = xcd_tile(it, 64 * 8); const int rt = tl_ >> 3, ct = tl_ & 7;
    f32x4 acc[8][4];
    zero_acc8(acc);
    gemm256(A + (size_t)rt * 256 * lda, lda, W + (size_t)ct * 128 * K, K, K, acc, lA, lB);
    const int row0 = rt * 256 + wm * 128;
    const float* xb = xsrc ? xsrc : (row0 < NCTX ? p.in[0] : p.in[1] - (size_t)NCTX * DM);
    const int ncol = ct * 128 + wn * 64 + (lane & 15);
    const float* gt = mod + cond_row(row0) * 6144 + ncol;
    float gv[4];
#pragma unroll
    for (int tn = 0; tn < 4; ++tn) gv[tn] = gt[tn * 16];
#pragma unroll
    for (int tm = 0; tm < 8; ++tm)
#pragma unroll
      for (int j = 0; j < 4; ++j) {
        const size_t o = (size_t)(row0 + tm * 16 + (lane >> 4) * 4 + j) * DM + ncol;
#pragma unroll
        for (int tn = 0; tn < 4; ++tn) X[o + tn * 16] = xb[o + tn * 16] + gv[tn] * acc[tm][tn][j];
      }
  }
}

DI void phase_ffn_gu(const Params& p, const bf16_t* W, unsigned char* smem) {
  unsigned char* ws = p.ws;
  bf16_t* lA = (bf16_t*)smem; bf16_t* lB = lA + 256 * LDK2;
  const int lane = threadIdx.x & 63, w = threadIdx.x >> 6, wm = w >> 1, wn = w & 1;
  const bf16_t* H = (const bf16_t*)(ws + OFF_H);
  bf16_t* HFF = (bf16_t*)(ws + OFF_HFF);
  for (int it = blockIdx.x; it < 64 * 44; it += p.gsz) {
    const int tl_ = xcd_tile(it, 64 * 44); const int rt = tl_ / 44, ct = tl_ % 44;
    f32x4 acc[8][4];
    zero_acc8(acc);
    gemm256(H + (size_t)rt * 256 * DM, DM, W + (size_t)ct * 128 * DM, DM, DM, acc, lA, lB);
#pragma unroll
    for (int tm = 0; tm < 8; ++tm)
#pragma unroll
      for (int j = 0; j < 4; ++j) {
        const int tok = rt * 256 + wm * 128 + tm * 16 + (lane >> 4) * 4 + j;
#pragma unroll
        for (int pp = 0; pp < 2; ++pp) {
          const int np = ct * 128 + wn * 64 + pp * 32;
          const int col = (np >> 5) * 16 + (lane & 15);
          const float gv = acc[tm][2 * pp][j], uv = acc[tm][2 * pp + 1][j];
          HFF[(size_t)tok * DFF + col] = f2bf(siluf(gv) * uv);
        }
      }
  }
}

DI void phase_l1_inproj(const Params& p, unsigned char* smem) {
  unsigned char* ws = p.ws;
  bf16_t* lA = (bf16_t*)smem; bf16_t* lB = lA + 256 * LDK2;
  const int lane = threadIdx.x & 63, w = threadIdx.x >> 6, wm = w >> 1, wn = w & 1;
  const int c = lane & 15;
  const bf16_t* H = (const bf16_t*)(ws + OFF_H);
  const bf16_t* W = (const bf16_t*)(ws + OFF_WIN1);
  bf16_t* Q1 = (bf16_t*)(ws + OFF_Q1); bf16_t* K1 = (bf16_t*)(ws + OFF_K1);
  bf16_t* VT = (bf16_t*)(ws + OFF_V1); bf16_t* G1 = (bf16_t*)(ws + OFF_G1);
  bf16_t* KTf = (bf16_t*)(ws + OFF_R4 + 64 * MBy); bf16_t* KTb = KTf + (size_t)64 * 1024 * 256;
  const float* scw = (const float*)(ws + OFF_SC1); const size_t NS1 = (size_t)NTOK * 4;
  const float2* rope1 = (const float2*)(ws + OFF_ROPE1);
  for (int it = blockIdx.x; it < 64 * 48; it += p.gsz) {
    const int tl_ = xcd_tile(it, 64 * 48); const int rt = tl_ / 48, ct = tl_ % 48;
    f32x4 acc[8][4];
    zero_acc8(acc);
    gemm256(H + (size_t)rt * 256 * DM, DM, W + (size_t)ct * 128 * DM, DM, DM, acc, lA, lB);
    const int row0 = rt * 256 + wm * 128, col0 = ct * 128 + wn * 64;
    const bool lat = row0 >= NCTX;
    if (col0 < 1024) {
      const int head = col0 >> 8, pos0 = col0 & 255;
#pragma unroll
      for (int pp = 0; pp < 2; ++pp) {
        const int i = ((pos0 >> 5) + pp) * 16 + c;
#pragma unroll
        for (int tm = 0; tm < 8; ++tm) {
#pragma unroll
          for (int j = 0; j < 4; ++j) {
            const int tok = row0 + tm * 16 + (lane >> 4) * 4 + j;
            float x1 = acc[tm][2 * pp][j], x2 = acc[tm][2 * pp + 1][j];
            if (lat) {
              const int tl = (tok - NCTX) & 4095;
              const float2 t = rope1[((i < 64) ? (tl >> 6) : (tl & 63)) * 64 + (i & 63)];
              const float z1 = x1 * t.x - x2 * t.y, z2 = x2 * t.x + x1 * t.y;
              x1 = z1; x2 = z2;
            }
            bf16_t* d = Q1 + (size_t)tok * 1024 + head * 256;
            d[i] = f2bf(x1); d[128 + i] = f2bf(x2);
          }
          asm volatile("" ::: "memory");
        }
      }
    } else if (col0 < 2048) {
      const int head = (col0 - 1024) >> 8, pos0 = col0 & 255;
#pragma unroll
      for (int tm = 0; tm < 8; ++tm) {
        const int t0 = row0 + tm * 16 + (lane >> 4) * 4;
        const int ch = t0 >> 8, tl0 = t0 & 255;
        float wf[4], wb[4];
#pragma unroll
        for (int j = 0; j < 4; ++j) { wf[j] = scw[2 * NS1 + (size_t)(t0 + j) * 4 + head]; wb[j] = scw[3 * NS1 + (size_t)(t0 + j) * 4 + head]; }
#pragma unroll
        for (int pp = 0; pp < 2; ++pp) {
          const int i = ((pos0 >> 5) + pp) * 16 + c;
          float y1[4], y2[4];
#pragma unroll
          for (int j = 0; j < 4; ++j) {
            const int tok = t0 + j;
            float x1 = acc[tm][2 * pp][j] * 0.0625f, x2 = acc[tm][2 * pp + 1][j] * 0.0625f;
            if (lat) {
              const int tl = (tok - NCTX) & 4095;
              const float2 t = rope1[((i < 64) ? (tl >> 6) : (tl & 63)) * 64 + (i & 63)];
              const float z1 = x1 * t.x - x2 * t.y, z2 = x2 * t.x + x1 * t.y;
              x1 = z1; x2 = z2;
            }
            y1[j] = x1; y2[j] = x2;
            bf16_t* d = K1 + (size_t)tok * 1024 + head * 256;
            d[i] = f2bf(x1); d[128 + i] = f2bf(x2);
          }
          const size_t r1 = ((size_t)ch * 1024 + head * 256 + i) * 256 + tl0, r2 = r1 + (size_t)128 * 256;
          uint2 u;
          u.x = pack2(y1[0] * wf[0], y1[1] * wf[1]); u.y = pack2(y1[2] * wf[2], y1[3] * wf[3]); *(uint2*)(KTf + r1) = u;
          u.x = pack2(y2[0] * wf[0], y2[1] * wf[1]); u.y = pack2(y2[2] * wf[2], y2[3] * wf[3]); *(uint2*)(KTf + r2) = u;
          u.x = pack2(y1[0] * wb[0], y1[1] * wb[1]); u.y = pack2(y1[2] * wb[2], y1[3] * wb[3]); *(uint2*)(KTb + r1) = u;
          u.x = pack2(y2[0] * wb[0], y2[1] * wb[1]); u.y = pack2(y2[2] * wb[2], y2[3] * wb[3]); *(uint2*)(KTb + r2) = u;
        }
        asm volatile("" ::: "memory");
      }
    } else if (col0 < 4096) {
      const int cb = col0 - 2048;
#pragma unroll
      for (int tm = 0; tm < 8; ++tm) {
        const int t0 = row0 + tm * 16 + (lane >> 4) * 4;
        const int ch = t0 >> 8, tl0 = t0 & 255;
#pragma unroll
        for (int tn = 0; tn < 4; ++tn) {
          uint2 u;
          u.x = pack2(acc[tm][tn][0], acc[tm][tn][1]); u.y = pack2(acc[tm][tn][2], acc[tm][tn][3]);
          *(uint2*)(VT + ((size_t)ch * 2048 + cb + tn * 16 + c) * 256 + tl0) = u;
        }
      }
    } else {
      const int cb = col0 - 4096;
#pragma unroll
      for (int tm = 0; tm < 8; ++tm)
#pragma unroll
        for (int j = 0; j < 4; ++j) {
          const int tok = row0 + tm * 16 + (lane >> 4) * 4 + j;
#pragma unroll
          for (int tn = 0; tn < 4; ++tn)
            G1[(size_t)tok * 2048 + cb + tn * 16 + c] = f2bf(siluf(acc[tm][tn][j]));
        }
    }
  }
}

DI void phase_ret_pds(const Params& p, unsigned char* smem) {
  unsigned char* ws = p.ws;
  const bf16_t* Q1 = (const bf16_t*)(ws + OFF_Q1);
  const bf16_t* K1 = (const bf16_t*)(ws + OFF_K1);
  const bf16_t* VT = (const bf16_t*)(ws + OFF_V1);
  const bf16_t* KTf = (const bf16_t*)(ws + OFF_R4 + 64 * MBy);
  const bf16_t* KTb = KTf + (size_t)64 * 1024 * 256;
  const float* sc = (const float*)(ws + OFF_SC1);
#pragma unroll 1
  for (int it = blockIdx.x; it < 4096; it += p.gsz) {
    const int t8 = it & 7, dir = (it >> 3) & 1, h = (it >> 4) & 3, c = it >> 6;
    const bf16_t* kt = (dir ? KTb : KTf) + ((size_t)c * 1024 + h * 256) * 256;
    const bf16_t* vt = VT + ((size_t)c * 2048 + h * 512) * 256;
    if (c < 32) {
      float* out = p.out + OUT_RET + (size_t)((c * 2 + dir) * 4 + h) * 131072;
      dsgemm_nt_tile(kt, vt, t8 >> 2, t8 & 3, out, nullptr, 512, smem);
    } else {
      const int b = (c - 32) >> 4, lc = (c - 32) & 15;
      bf16_t* outb = (bf16_t*)(ws + OFF_DS1) + (size_t)(((b * 16 + lc) * 4 + h) * 2 + dir) * 131072;
      dsgemm_nt_tile(vt, kt, t8 >> 1, t8 & 1, nullptr, outb, 256, smem);
    }
  }
#pragma unroll 1
  for (int i = blockIdx.x; i < 1024; i += p.gsz) {
    const int c = i >> 4, h = (i >> 2) & 3, ti = (i >> 1) & 1, tj = i & 1, tok0 = c * 256;
    pgemm_tile(Q1 + (size_t)tok0 * 1024 + h * 256, 1024, K1 + (size_t)tok0 * 1024 + h * 256, 1024, 256, sc, 4, h, tok0, ti, tj,
               (bf16_t*)(ws + OFF_P1) + (size_t)(c * 4 + h) * 65536, smem);
  }
}

DI void phase_ret_scan(const Params& p) {
  unsigned char* ws = p.ws;
  const float* sc = (const float*)(ws + OFF_SC1);
  const size_t NS = (size_t)NTOK * 4;
  const float* CUMF = sc + 4 * NS; const float* CUMB = sc + 5 * NS;
  const bf16_t* DS = (const bf16_t*)(ws + OFF_DS1);
  bf16_t* SST0p = (bf16_t*)(ws + OFF_K1); bf16_t* SST1p = (bf16_t*)(ws + OFF_SST1B);
  for (int idx = blockIdx.x * 256 + threadIdx.x; idx < 2097152; idx += p.gsz * 256) {
    const int e = idx & 131071, dir = (idx >> 17) & 1, h = (idx >> 18) & 3, b = idx >> 20;
    float S = p.in[6][(size_t)((b * 2 + dir) * 4 + h) * 131072 + (size_t)(e & 255) * 512 + (e >> 8)];
    float dsv[16];
#pragma unroll
    for (int s = 0; s < 16; ++s) {
      const int lc = dir ? 15 - s : s;
      dsv[s] = bf2f(__builtin_nontemporal_load(DS + (size_t)(((b * 16 + lc) * 4 + h) * 2 + dir) * 131072 + e));
    }
    const int c0 = 32 + b * 16;
    const float dec = __expf(dir ? CUMB[(size_t)(c0 * 256) * 4 + h] : CUMF[(size_t)(c0 * 256 + 255) * 4 + h]);
    bf16_t* dst = b ? SST1p : SST0p;
#pragma unroll
    for (int s = 0; s < 16; ++s) {
      const int lc = dir ? 15 - s : s;
      dst[(size_t)((lc * 4 + h) * 2 + dir) * 131072 + e] = f2bf(S);
      S = dec * S + dsv[s];
    }
  }
}

DI void phase_ret_y(const Params& p, unsigned char* smem) {
  unsigned char* ws = p.ws;
  bf16_t* lA = (bf16_t*)smem; bf16_t* lB = lA + 128 * LDK;
  const int lane = threadIdx.x & 63, w = threadIdx.x >> 6, wm = w >> 1, wn = w & 1;
  const bf16_t* Q1 = (const bf16_t*)(ws + OFF_Q1);
  const bf16_t* VT = (const bf16_t*)(ws + OFF_V1);
  const bf16_t* P1 = (const bf16_t*)(ws + OFF_P1);
  const bf16_t* SST0p = (const bf16_t*)(ws + OFF_K1); const bf16_t* SST1p = (const bf16_t*)(ws + OFF_SST1B);
  const float* sc = (const float*)(ws + OFF_SC1);
  const size_t NS = (size_t)NTOK * 4;
  bf16_t* Y1 = (bf16_t*)(ws + OFF_Y1);
  for (int it = blockIdx.x; it < 2048; it += p.gsz) {
    const int tni = it & 3, ti = (it >> 2) & 1, h = (it >> 3) & 3, c = it >> 5, tok0 = c * 256;
    f32x4 acc[4][4];
    zero_acc(acc);
    gemm_seg<false, false>(P1 + ((size_t)(c * 4 + h) * 256 + ti * 128) * 256, 256, nullptr, 0, 128,
                           VT + ((size_t)c * 2048 + h * 512 + tni * 128) * 256, 256, nullptr, 0, 128, 256, acc, lA, lB);
    if (c >= 32) {
      const int b = (c - 32) >> 4, lc = (c - 32) & 15;
#pragma unroll 1
      for (int dir = 0; dir < 2; ++dir)
        gemm_seg<false, false>(Q1 + (size_t)(tok0 + ti * 128) * 1024 + h * 256, 1024, sc + dir * NS + (size_t)(tok0 + ti * 128) * 4 + h, 4, 128,
                               (b ? SST1p : SST0p) + (size_t)((lc * 4 + h) * 2 + dir) * 131072 + (size_t)tni * 128 * 256, 256, nullptr, 0, 128, 256, acc, lA, lB);
    }
#pragma unroll
    for (int tm = 0; tm < 4; ++tm)
#pragma unroll
      for (int j = 0; j < 4; ++j) {
        const int tok = tok0 + ti * 128 + wm * 64 + tm * 16 + (lane >> 4) * 4 + j;
#pragma unroll
        for (int tn = 0; tn < 4; ++tn)
          Y1[(size_t)tok * 2048 + h * 512 + tni * 128 + wn * 64 + tn * 16 + (lane & 15)] = f2bf(acc[tm][tn][j]);
      }
  }
}

DI void phase_ret_norm(const Params& p) {
  unsigned char* ws = p.ws;
  const int lane = threadIdx.x & 63, w = threadIdx.x >> 6;
  const bf16_t* Y1 = (const bf16_t*)(ws + OFF_Y1);
  const bf16_t* G1 = (const bf16_t*)(ws + OFF_G1);
  bf16_t* A2 = (bf16_t*)(ws + OFF_A2);
  const float* gain = p.in[32];
  for (int tok = blockIdx.x * 4 + w; tok < NTOK; tok += p.gsz * 4) {
    const size_t base = (size_t)tok * 2048;
    float4 v[4][2];
    uint2 gg[4][2];
#pragma unroll
    for (int h = 0; h < 4; ++h)
#pragma unroll
      for (int i = 0; i < 2; ++i) {
        { const uint2 yy = *(const uint2*)(Y1 + base + h * 512 + i * 256 + lane * 4);
          v[h][i] = make_float4(__uint_as_float(yy.x << 16), __uint_as_float(yy.x & 0xffff0000u), __uint_as_float(yy.y << 16), __uint_as_float(yy.y & 0xffff0000u)); }
        gg[h][i] = *(const uint2*)(G1 + base + h * 512 + i * 256 + lane * 4);
      }
#pragma unroll
    for (int h = 0; h < 4; ++h) {
      float ss = 0.f;
#pragma unroll
      for (int i = 0; i < 2; ++i) ss += v[h][i].x * v[h][i].x + v[h][i].y * v[h][i].y + v[h][i].z * v[h][i].z + v[h][i].w * v[h][i].w;
      ss = wave_sum(ss);
      const float rinv = rsqrtf(ss * (1.f / 512.f) + EPSF);
#pragma unroll
      for (int i = 0; i < 2; ++i) {
        const int col = h * 512 + i * 256 + lane * 4;
        const float4 g = *(const float4*)(gain + col);
        uint2 pk;
        pk.x = pack2(v[h][i].x * rinv * g.x * __uint_as_float(gg[h][i].x << 16), v[h][i].y * rinv * g.y * __uint_as_float(gg[h][i].x & 0xffff0000u));
        pk.y = pack2(v[h][i].z * rinv * g.z * __uint_as_float(gg[h][i].y << 16), v[h][i].w * rinv * g.w * __uint_as_float(gg[h][i].y & 0xffff0000u));
        *(uint2*)(A2 + base + col) = pk;
      }
    }
  }
}

DI void phase_final(const Params& p) {
  const int lane = threadIdx.x & 63, w = threadIdx.x >> 6;
  const float* X = (const float*)(p.ws + OFF_X);
  const float* gain = p.in[36];
  for (int tok = (blockIdx.x * 4 + w) * 2; tok < NTOK; tok += p.gsz * 8) {
    float4 v[2][4];
#pragma unroll
    for (int r = 0; r < 2; ++r)
#pragma unroll
      for (int i = 0; i < 4; ++i) {
        const float* xp = X + (size_t)(tok + r) * DM + i * 256 + lane * 4;
        v[r][i] = make_float4(__builtin_nontemporal_load(xp), __builtin_nontemporal_load(xp + 1), __builtin_nontemporal_load(xp + 2), __builtin_nontemporal_load(xp + 3));
      }
    float rinv[2];
#pragma unroll
    for (int r = 0; r < 2; ++r) {
      float ss = 0.f;
#pragma unroll
      for (int i = 0; i < 4; ++i) ss += v[r][i].x * v[r][i].x + v[r][i].y * v[r][i].y + v[r][i].z * v[r][i].z + v[r][i].w * v[r][i].w;
      ss = wave_sum(ss);
      rinv[r] = rsqrtf(ss * (1.f / 1024.f) + EPSF);
    }
#pragma unroll
    for (int i = 0; i < 4; ++i) {
      const int col = i * 256 + lane * 4;
      const float4 g = *(const float4*)(gain + col);
#pragma unroll
      for (int r = 0; r < 2; ++r) {
        float4 o;
        o.x = v[r][i].x * rinv[r] * g.x; o.y = v[r][i].y * rinv[r] * g.y; o.z = v[r][i].z * rinv[r] * g.z; o.w = v[r][i].w * rinv[r] * g.w;
        float* yo = p.out + OUT_Y + (size_t)(tok + r) * DM + col;
        __builtin_nontemporal_store(o.x, yo); __builtin_nontemporal_store(o.y, yo + 1);
        __builtin_nontemporal_store(o.z, yo + 2); __builtin_nontemporal_store(o.w, yo + 3);
      }
    }
  }
}

#define XB_TMO      128
#define XB_XCNT(j)  (256  + 64 * (j))
#define XB_XSUB(j)  (1280 + 64 * (j))
#define XB_XGEN(j)  (2304 + 64 * (j))
#define XB_TOP      3328
#define XB_TOPGEN   3392
#define XCD_BAR_WORDS 3456
#define XB_SPIN_CAP (1u << 22)
#define LAS __attribute__((address_space(3)))
DI unsigned xb_ld(unsigned* p) { return __hip_atomic_load(p, __ATOMIC_RELAXED, __HIP_MEMORY_SCOPE_AGENT); }
DI unsigned xb_add(unsigned* p, unsigned v) { return __hip_atomic_fetch_add(p, v, __ATOMIC_RELAXED, __HIP_MEMORY_SCOPE_AGENT); }
DI unsigned xb_xcc_id() { return (unsigned)__builtin_amdgcn_s_getreg((3 << 11) | 20) & 0xFu; }
#define XB_SPIN(cond, bar) do { unsigned _sp = 0; while (cond) { __builtin_amdgcn_s_sleep(1); \
    if ((++_sp & 255u) == 0u) { if (xb_ld(&(bar)[XB_TMO])) break; if (_sp > XB_SPIN_CAP) { atomicAdd(&(bar)[XB_TMO], 1u); break; } } } } while (0)
struct XcdBarrier { unsigned* bar; unsigned x; volatile unsigned* st; };
DI XcdBarrier xcd_barrier_post(unsigned* bar, volatile unsigned* st) {
  XcdBarrier b; b.bar = bar; b.x = xb_xcc_id(); b.st = st;
  if (threadIdx.x == 0) (void)xb_add(&bar[XB_XCNT(b.x)], 1u);
  return b;
}
DI void xcd_barrier_complete(unsigned* bar, unsigned x, unsigned& nloc, unsigned& nx) {
  const unsigned G = gridDim.x;
  unsigned sum, cnt, mine, sp = 0u;
  for (;;) {
    sum = 0u; cnt = 0u; mine = 0u;
#pragma unroll
    for (unsigned j = 0; j < 16; ++j) { const unsigned c = xb_ld(&bar[XB_XCNT(j)]); sum += c; cnt += (c > 0u) ? 1u : 0u; mine = (j == x) ? c : mine; }
    if (sum == G) break;
    __builtin_amdgcn_s_sleep(1);
    if ((++sp & 255u) == 0u) { if (xb_ld(&bar[XB_TMO])) break; if (sp > XB_SPIN_CAP) { atomicAdd(&bar[XB_TMO], 1u); break; } }
  }
  nloc = mine > 0u ? mine : 1u; nx = cnt > 0u ? cnt : 1u;
}
DI void xcd_barrier(const XcdBarrier& b) {
  asm volatile("s_waitcnt vmcnt(0)" ::: "memory");
  __syncthreads();
  if (threadIdx.x == 0) {
    unsigned* bar = b.bar;
    __builtin_amdgcn_s_waitcnt(0);
    unsigned nloc = b.st[0], nx = b.st[1];
    if (nloc == 0u) { xcd_barrier_complete(bar, b.x, nloc, nx); b.st[0] = nloc; b.st[1] = nx; }
    const unsigned old = xb_add(&bar[XB_XSUB(b.x)], 1u);
    const unsigned gen = old / nloc;
    if (old + 1u == (gen + 1u) * nloc) {
      __builtin_amdgcn_fence(__ATOMIC_RELEASE, "agent");
      asm volatile("s_waitcnt vmcnt(0)" ::: "memory");
      const unsigned og = xb_add(&bar[XB_TOP], 1u);
      const unsigned tg = og / nx;
      if (og + 1u == (tg + 1u) * nx) xb_add(&bar[XB_TOPGEN], 1u);
      else XB_SPIN(xb_ld(&bar[XB_TOPGEN]) == tg, bar);
      __builtin_amdgcn_fence(__ATOMIC_ACQUIRE, "agent");
      xb_add(&bar[XB_XGEN(b.x)], 1u);
      asm volatile("s_waitcnt vmcnt(0)" ::: "memory");
    } else {
      XB_SPIN(xb_ld(&bar[XB_XGEN(b.x)]) == gen, bar);
      __builtin_amdgcn_fence(__ATOMIC_ACQUIRE, "agent");
      asm volatile("s_waitcnt vmcnt(0)" ::: "memory");
    }
  }
  __syncthreads();
}

__global__ void __launch_bounds__(256, LB_MIN) mega(Params p) {
  __shared__ __attribute__((aligned(16))) unsigned char smem[40960];
  __shared__ __attribute__((aligned(16))) unsigned bar_st[4];
  cg::grid_group grid = cg::this_grid();
  unsigned char* ws = p.ws;
#if ONE_LAUNCH
  if (threadIdx.x == 0) { bar_st[0] = 0u; bar_st[1] = 0u; }
  __syncthreads();
  const XcdBarrier xb = xcd_barrier_post((unsigned*)(ws + OFF_BAR), bar_st);
#endif
#if ONE_LAUNCH
  p.gsz = ((PH_LIMIT_MASK >> 0) & 1) ? (int)(gridDim.x >> 1) : (int)gridDim.x;
  if ((int)blockIdx.x < p.gsz)
  {phase0(p, smem); }
  xcd_barrier(xb);
  if (p.ph_lo < 0) grid.sync();
  p.gsz = ((PH_LIMIT_MASK >> 1) & 1) ? (int)(gridDim.x >> 1) : (int)gridDim.x;
  if ((int)blockIdx.x < p.gsz)
  {phase_normmod(p, nullptr, p.in[10], 0, 0, 1); }
  xcd_barrier(xb);
  p.gsz = ((PH_LIMIT_MASK >> 2) & 1) ? (int)(gridDim.x >> 1) : (int)gridDim.x;
  if ((int)blockIdx.x < p.gsz)
  {phase_l0_inproj(p, smem); }
  xcd_barrier(xb);
  p.gsz = ((PH_LIMIT_MASK >> 3) & 1) ? (int)(gridDim.x >> 1) : (int)gridDim.x;
  if ((int)blockIdx.x < p.gsz)
  {for (int it = blockIdx.x; it < 640 + 1024; it += p.gsz) {
          if (it < 640) ssd_prep_item(p, it, smem);
          else attn_item(p, it - 640, smem);
        } }
  xcd_barrier(xb);
  p.gsz = ((PH_LIMIT_MASK >> 4) & 1) ? (int)(gridDim.x >> 1) : (int)gridDim.x;
  if ((int)blockIdx.x < p.gsz)
  {phase_ssd_pds(p, smem); }
  xcd_barrier(xb);
  p.gsz = ((PH_LIMIT_MASK >> 5) & 1) ? (int)(gridDim.x >> 1) : (int)gridDim.x;
  if ((int)blockIdx.x < p.gsz)
  {phase_ssd_scan(p); }
  xcd_barrier(xb);
  p.gsz = ((PH_LIMIT_MASK >> 6) & 1) ? (int)(gridDim.x >> 1) : (int)gridDim.x;
  if ((int)blockIdx.x < p.gsz)
  {phase_ssd_y(p, smem); }
  xcd_barrier(xb);
  p.gsz = ((PH_LIMIT_MASK >> 7) & 1) ? (int)(gridDim.x >> 1) : (int)gridDim.x;
  if ((int)blockIdx.x < p.gsz)
  {phase_ssd_norm(p); }
  xcd_barrier(xb);
  p.gsz = ((PH_LIMIT_MASK >> 8) & 1) ? (int)(gridDim.x >> 1) : (int)gridDim.x;
  if ((int)blockIdx.x < p.gsz)
  {phase_res_gemm(p, (const bf16_t*)(ws + OFF_AOUT), DM, DM, (const bf16_t*)(ws + OFF_WOUT0), nullptr, 0, 2, smem); }
  xcd_barrier(xb);
  p.gsz = ((PH_LIMIT_MASK >> 9) & 1) ? (int)(gridDim.x >> 1) : (int)gridDim.x;
  if ((int)blockIdx.x < p.gsz)
  {phase_normmod(p, (const float*)(ws + OFF_X), p.in[11], 0, 3, 4); }
  xcd_barrier(xb);
  p.gsz = ((PH_LIMIT_MASK >> 10) & 1) ? (int)(gridDim.x >> 1) : (int)gridDim.x;
  if ((int)blockIdx.x < p.gsz)
  {phase_ffn_gu(p, (const bf16_t*)(ws + OFF_WGU0), smem); }
  xcd_barrier(xb);
  p.gsz = ((PH_LIMIT_MASK >> 11) & 1) ? (int)(gridDim.x >> 1) : (int)gridDim.x;
  if ((int)blockIdx.x < p.gsz)
  {phase_res_gemm(p, (const bf16_t*)(ws + OFF_HFF), DFF, DFF, (const bf16_t*)(ws + OFF_WDN0), (const float*)(ws + OFF_X), 0, 5, smem); }
  xcd_barrier(xb);
  p.gsz = ((PH_LIMIT_MASK >> 12) & 1) ? (int)(gridDim.x >> 1) : (int)gridDim.x;
  if ((int)blockIdx.x < p.gsz)
  {phase_normmod(p, (const float*)(ws + OFF_X), p.in[27], 1, 0, 1); }
  xcd_barrier(xb);
  p.gsz = ((PH_LIMIT_MASK >> 13) & 1) ? (int)(gridDim.x >> 1) : (int)gridDim.x;
  if ((int)blockIdx.x < p.gsz)
  {phase_l1_inproj(p, smem); }
  xcd_barrier(xb);
  p.gsz = ((PH_LIMIT_MASK >> 14) & 1) ? (int)(gridDim.x >> 1) : (int)gridDim.x;
  if ((int)blockIdx.x < p.gsz)
  {phase_ret_pds(p, smem); }
  xcd_barrier(xb);
  p.gsz = ((PH_LIMIT_MASK >> 15) & 1) ? (int)(gridDim.x >> 1) : (int)gridDim.x;
  if ((int)blockIdx.x < p.gsz)
  {phase_ret_scan(p); }
  xcd_barrier(xb);
  p.gsz = ((PH_LIMIT_MASK >> 16) & 1) ? (int)(gridDim.x >> 1) : (int)gridDim.x;
  if ((int)blockIdx.x < p.gsz)
  {phase_ret_y(p, smem); }
  xcd_barrier(xb);
  p.gsz = ((PH_LIMIT_MASK >> 17) & 1) ? (int)(gridDim.x >> 1) : (int)gridDim.x;
  if ((int)blockIdx.x < p.gsz)
  {phase_ret_norm(p); }
  xcd_barrier(xb);
  p.gsz = ((PH_LIMIT_MASK >> 18) & 1) ? (int)(gridDim.x >> 1) : (int)gridDim.x;
  if ((int)blockIdx.x < p.gsz)
  {phase_res_gemm(p, (const bf16_t*)(ws + OFF_A2), 2048, 2048, (const bf16_t*)(ws + OFF_WOUT1), (const float*)(ws + OFF_X), 1, 2, smem); }
  xcd_barrier(xb);
  p.gsz = ((PH_LIMIT_MASK >> 19) & 1) ? (int)(gridDim.x >> 1) : (int)gridDim.x;
  if ((int)blockIdx.x < p.gsz)
  {phase_normmod(p, (const float*)(ws + OFF_X), p.in[28], 1, 3, 4); }
  xcd_barrier(xb);
  p.gsz = ((PH_LIMIT_MASK >> 20) & 1) ? (int)(gridDim.x >> 1) : (int)gridDim.x;
  if ((int)blockIdx.x < p.gsz)
  {phase_ffn_gu(p, (const bf16_t*)(ws + OFF_WGU1), smem); }
  xcd_barrier(xb);
  p.gsz = ((PH_LIMIT_MASK >> 21) & 1) ? (int)(gridDim.x >> 1) : (int)gridDim.x;
  if ((int)blockIdx.x < p.gsz)
  {phase_res_gemm(p, (const bf16_t*)(ws + OFF_HFF), DFF, DFF, (const bf16_t*)(ws + OFF_WDN1), (const float*)(ws + OFF_X), 1, 5, smem); }
  xcd_barrier(xb);
  p.gsz = ((PH_LIMIT_MASK >> 22) & 1) ? (int)(gridDim.x >> 1) : (int)gridDim.x;
  if ((int)blockIdx.x < p.gsz)
  {phase_final(p); }
#else
  p.gsz = gridDim.x;
  switch (p.ph_lo) {
    case 0: {phase0(p, smem); } break;
    case 1: {phase_normmod(p, nullptr, p.in[10], 0, 0, 1); } break;
    case 2: {phase_l0_inproj(p, smem); } break;
    case 3: {for (int it = blockIdx.x; it < 640 + 1024; it += p.gsz) {
          if (it < 640) ssd_prep_item(p, it, smem);
          else attn_item(p, it - 640, smem);
        } } break;
    case 4: {phase_ssd_pds(p, smem); } break;
    case 5: {phase_ssd_scan(p); } break;
    case 6: {phase_ssd_y(p, smem); } break;
    case 7: {phase_ssd_norm(p); } break;
    case 8: {phase_res_gemm(p, (const bf16_t*)(ws + OFF_AOUT), DM, DM, (const bf16_t*)(ws + OFF_WOUT0), nullptr, 0, 2, smem); } break;
    case 9: {phase_normmod(p, (const float*)(ws + OFF_X), p.in[11], 0, 3, 4); } break;
    case 10: {phase_ffn_gu(p, (const bf16_t*)(ws + OFF_WGU0), smem); } break;
    case 11: {phase_res_gemm(p, (const bf16_t*)(ws + OFF_HFF), DFF, DFF, (const bf16_t*)(ws + OFF_WDN0), (const float*)(ws + OFF_X), 0, 5, smem); } break;
    case 12: {phase_normmod(p, (const float*)(ws + OFF_X), p.in[27], 1, 0, 1); } break;
    case 13: {phase_l1_inproj(p, smem); } break;
    case 14: {phase_ret_pds(p, smem); } break;
    case 15: {phase_ret_scan(p); } break;
    case 16: {phase_ret_y(p, smem); } break;
    case 17: {phase_ret_norm(p); } break;
    case 18: {phase_res_gemm(p, (const bf16_t*)(ws + OFF_A2), 2048, 2048, (const bf16_t*)(ws + OFF_WOUT1), (const float*)(ws + OFF_X), 1, 2, smem); } break;
    case 19: {phase_normmod(p, (const float*)(ws + OFF_X), p.in[28], 1, 3, 4); } break;
    case 20: {phase_ffn_gu(p, (const bf16_t*)(ws + OFF_WGU1), smem); } break;
    case 21: {phase_res_gemm(p, (const bf16_t*)(ws + OFF_HFF), DFF, DFF, (const bf16_t*)(ws + OFF_WDN1), (const float*)(ws + OFF_X), 1, 5, smem); } break;
    case 22: {phase_final(p); } break;
    default: break;
  }
  if (p.ph_hi < 0) grid.sync();
#endif
}

__global__ void trap_kernel() { __builtin_trap(); }

extern "C" void kernel_launch(void* const* d_in, const int* in_sizes, int n_in, void* d_out, int out_size, void* d_ws, size_t ws_size,
                              hipStream_t stream) {
  if (ws_size < WS_NEED || n_in != 37) {
    fprintf(stderr, "kernel_launch: workspace too small (%zu < %zu) or n_in %d != 37\n", ws_size, (size_t)WS_NEED, n_in);
    hipLaunchKernelGGL(trap_kernel, dim3(1), dim3(64), 0, stream);
    return;
  }
  static int grid_blocks = 0;
  if (!grid_blocks) {
    int dev = 0, cus = 0, per_cu = 0;
    hipGetDevice(&dev);
    hipDeviceGetAttribute(&cus, hipDeviceAttributeMultiprocessorCount, dev);
    hipOccupancyMaxActiveBlocksPerMultiprocessor(&per_cu, (const void*)mega, 256, 0);
    if (per_cu < 1) per_cu = 1;
    if (per_cu > 2) per_cu = 2;
    grid_blocks = cus * per_cu;
  }
  Params p{};
  for (int i = 0; i < 37; ++i) p.in[i] = (const float*)d_in[i];
  p.out = (float*)d_out;
  p.ws = (unsigned char*)d_ws;
#if ONE_LAUNCH
  p.ph_lo = 0; p.ph_hi = NPH;
  (void)hipMemsetAsync((unsigned char*)d_ws + OFF_BAR, 0, XCD_BAR_WORDS * 4, stream);
  void* args[] = {&p};
  hipError_t e = hipLaunchCooperativeKernel((const void*)mega, dim3(grid_blocks), dim3(256), args, 0, stream);
  if (e != hipSuccess) fprintf(stderr, "cooperative launch failed: %s (grid %d)\n", hipGetErrorString(e), grid_blocks);
#else
  for (int ph = 0; ph < NPH; ++ph) {
    p.ph_lo = ph; p.ph_hi = ph + 1;
    for (int rep = 0; rep <= ((REPEAT_MASK >> ph) & 1) * REPEAT_N; ++rep)
      hipLaunchKernelGGL(mega, dim3(((PH_LIMIT_MASK >> ph) & 1) ? grid_blocks / 2 : grid_blocks), dim3(256), 0, stream, p);
  }
#endif
}
```

```cpp
#include <hip/hip_runtime.h>
#include <hip/hip_cooperative_groups.h>
#include <cstdio>
namespace cg = cooperative_groups;

#ifndef ONE_LAUNCH
#define ONE_LAUNCH 1
#endif

#ifndef PH_LIMIT_MASK
#define PH_LIMIT_MASK 0x2000
#endif
#ifndef REPEAT_MASK
#define REPEAT_MASK 0
#endif
#ifndef REPEAT_N
#define REPEAT_N 1
#endif
#ifndef LB_MIN
#define LB_MIN 2
#endif
#define DI __device__ __forceinline__
typedef unsigned short bf16_t;
using bf16x8 = __attribute__((ext_vector_type(8))) short;
using f32x4 = __attribute__((ext_vector_type(4))) float;

constexpr int NTOK = 16384;
constexpr int NCTX = 8192;
constexpr int DM = 1024;
constexpr int DFF = 2816;
constexpr float EPSF = 1e-6f;
constexpr int NPH = 23;

constexpr size_t MBy = 1048576;
constexpr size_t OFF_WIN0 = 0;
constexpr size_t OFF_WOUT0 = OFF_WIN0 + (size_t)2176 * 1024 * 2;
constexpr size_t OFF_WGU0 = OFF_WOUT0 + (size_t)1024 * 1024 * 2;
constexpr size_t OFF_WDN0 = OFF_WGU0 + (size_t)5632 * 1024 * 2;
constexpr size_t OFF_WIN1 = OFF_WDN0 + (size_t)1024 * 2816 * 2;
constexpr size_t OFF_WOUT1 = OFF_WIN1 + (size_t)6144 * 1024 * 2;
constexpr size_t OFF_WGU1 = OFF_WOUT1 + (size_t)1024 * 2048 * 2;
constexpr size_t OFF_WDN1 = OFF_WGU1 + (size_t)5632 * 1024 * 2;
constexpr size_t OFF_MOD = OFF_WDN1 + (size_t)1024 * 2816 * 2;
constexpr size_t OFF_SC0 = OFF_MOD + (size_t)2 * 3 * 6144 * 4;
constexpr size_t OFF_SC1 = OFF_SC0 + (size_t)8 * NTOK * 8 * 4;
constexpr size_t OFF_ROPE0 = OFF_SC1 + (size_t)8 * NTOK * 4 * 4;
constexpr size_t OFF_ROPE1 = OFF_ROPE0 + 8192;
constexpr size_t OFF_BAR = OFF_ROPE1 + 32768;
constexpr size_t OFF_X = 64 * MBy;
constexpr size_t OFF_H = OFF_X + 64 * MBy;
constexpr size_t OFF_R1 = OFF_H + 32 * MBy;
constexpr size_t OFF_R2 = OFF_R1 + 64 * MBy;
constexpr size_t OFF_R3 = OFF_R2 + 64 * MBy;
constexpr size_t OFF_R4 = OFF_R3 + 64 * MBy;
constexpr size_t OFF_SST1B = OFF_R4 + 128 * MBy;
constexpr size_t WS_NEED = OFF_SST1B + 32 * MBy;
static_assert(OFF_BAR + 16384 <= OFF_X, "weights region overflow");
constexpr size_t OFF_Q0 = OFF_R1;
constexpr size_t OFF_KC = OFF_Q0 + 16 * MBy;
constexpr size_t OFF_VC = OFF_KC + 2 * MBy;
constexpr size_t OFF_KL = OFF_VC + 2 * MBy;
constexpr size_t OFF_VL = OFF_KL + 3 * MBy;
constexpr size_t OFF_ZS = OFF_VL + 3 * MBy;
constexpr size_t OFF_VS = OFF_ZS + 16 * MBy;
static_assert(OFF_VS + 16 * MBy <= OFF_R2, "R1 overflow");
constexpr size_t OFF_Q1 = OFF_R1;
constexpr size_t OFF_K1 = OFF_R1 + 32 * MBy;
constexpr size_t OFF_SST1 = OFF_R1;
constexpr size_t OFF_XS = OFF_R2;
constexpr size_t OFF_YG = OFF_R2 + 32 * MBy;
constexpr size_t OFF_V1 = OFF_R2;
constexpr size_t OFF_A2 = OFF_R2;
constexpr size_t OFF_XBC = OFF_R3;
constexpr size_t OFF_DT = OFF_XBC + 48 * MBy;
constexpr size_t OFF_CC = OFF_DT + 1 * MBy;
constexpr size_t OFF_BB = OFF_CC + 4 * MBy;
static_assert(OFF_BB + 4 * MBy <= OFF_R4, "R3 overflow");
constexpr size_t OFF_G1 = OFF_R3;
constexpr size_t OFF_P0 = OFF_R4;
constexpr size_t OFF_DS0 = OFF_P0 + 64 * MBy;
constexpr size_t OFF_SST0 = OFF_DS0 + 16 * MBy;
constexpr size_t OFF_AOUT = OFF_SST0 + 8 * MBy;
static_assert(OFF_AOUT + 32 * MBy <= WS_NEED, "R4 overflow");
constexpr size_t OFF_HFF = OFF_R4;
constexpr size_t OFF_DS1 = OFF_R4;
constexpr size_t OFF_Y1 = OFF_R4;
constexpr size_t OFF_P1 = OFF_H;

constexpr size_t OUT_Y = 0;
constexpr size_t OUT_K0 = 16777216;
constexpr size_t OUT_V0 = OUT_K0 + 1048576;
constexpr size_t OUT_SSD = OUT_V0 + 1048576;
constexpr size_t OUT_RET = OUT_SSD + 2097152;

struct Params {
  const float* in[37];
  float* out;
  unsigned char* ws;
  int ph_lo, ph_hi;
  int gsz, pad_;
};

typedef __bf16 bf16x2_t __attribute__((ext_vector_type(2)));
DI bf16_t f2bf(float x) { const __bf16 h = (__bf16)x; return __builtin_bit_cast(bf16_t, h); }
DI float bf2f(bf16_t h) { return __uint_as_float(((unsigned)h) << 16); }
DI unsigned pack2(float a, float b) { const bf16x2_t v = {(__bf16)a, (__bf16)b}; return __builtin_bit_cast(unsigned, v); }
DI float siluf(float x) { return x * __builtin_amdgcn_rcpf(1.f + __builtin_amdgcn_exp2f(-1.4426950408889634f * x)); }
DI unsigned scale2(unsigned w, float s) {
  float lo = __uint_as_float(w << 16) * s, hi = __uint_as_float(w & 0xffff0000u) * s;
  return pack2(lo, hi);
}
DI uint4 scale8(uint4 v, float s) {
  v.x = scale2(v.x, s); v.y = scale2(v.y, s); v.z = scale2(v.z, s); v.w = scale2(v.w, s);
  return v;
}
DI float wave_sum(float v) {
#pragma unroll
  for (int o = 32; o >= 1; o >>= 1) v += __shfl_xor(v, o, 64);
  return v;
}
DI float sum16(float v) {
  v += __shfl_xor(v, 1, 64); v += __shfl_xor(v, 2, 64); v += __shfl_xor(v, 4, 64); v += __shfl_xor(v, 8, 64);
  return v;
}
DI float max16(float v) {
  v = fmaxf(v, __shfl_xor(v, 1, 64)); v = fmaxf(v, __shfl_xor(v, 2, 64));
  v = fmaxf(v, __shfl_xor(v, 4, 64)); v = fmaxf(v, __shfl_xor(v, 8, 64));
  return v;
}
DI void sincos_rev(float ang, float& s, float& c) {
  float r = ang * 0.15915494309189535f;
  r = r - rintf(r);
  s = __builtin_amdgcn_sinf(r);
  c = __builtin_amdgcn_cosf(r);
}
DI const float* xin_row(const Params& p, int tok) {
  return tok < NCTX ? p.in[0] + (size_t)tok * DM : p.in[1] + (size_t)(tok - NCTX) * DM;
}
DI int cond_row(int tok) { return tok < NCTX ? 0 : 1 + ((tok - NCTX) >> 12); }

constexpr int LDK = 72;

template <bool TR>
DI void tile_load(const bf16_t* __restrict__ P, int ld, const float* __restrict__ sc, int ss, int lim, int k0, uint4 (&r)[4]) {
  const int tid = threadIdx.x;
#pragma unroll
  for (int i = 0; i < 4; ++i) {
    const int id = tid + i * 256;
    uint4 v = make_uint4(0u, 0u, 0u, 0u);
    if (!TR) {
      const int row = id >> 3, kc = id & 7;
      if (row < lim) {
        v = *(const uint4*)(P + (size_t)row * ld + k0 + kc * 8);
        if (sc) v = scale8(v, sc[(size_t)row * ss]);
      }
    } else {
      const int kr = id >> 4, mc = id & 15;
      if (mc * 8 < lim) {
        v = *(const uint4*)(P + (size_t)(k0 + kr) * ld + mc * 8);
        if (sc) v = scale8(v, sc[(size_t)(k0 + kr) * ss]);
      }
    }
    r[i] = v;
  }
}
template <bool TR>
DI void tile_store(bf16_t* L, const uint4 (&r)[4]) {
  const int tid = threadIdx.x;
#pragma unroll
  for (int i = 0; i < 4; ++i) {
    const int id = tid + i * 256;
    if (!TR) {
      const int row = id >> 3, kc = id & 7;
      *(uint4*)(L + row * LDK + kc * 8) = r[i];
    } else {
      const int kr = id >> 4, mc = id & 15;
      bf16_t* q = L + (mc * 8) * LDK + kr;
      q[0 * LDK] = (bf16_t)(r[i].x & 0xffffu); q[1 * LDK] = (bf16_t)(r[i].x >> 16);
      q[2 * LDK] = (bf16_t)(r[i].y & 0xffffu); q[3 * LDK] = (bf16_t)(r[i].y >> 16);
      q[4 * LDK] = (bf16_t)(r[i].z & 0xffffu); q[5 * LDK] = (bf16_t)(r[i].z >> 16);
      q[6 * LDK] = (bf16_t)(r[i].w & 0xffffu); q[7 * LDK] = (bf16_t)(r[i].w >> 16);
    }
  }
}

template <bool TRA, bool TRB>
DI void gemm_seg(const bf16_t* __restrict__ A, int lda, const float* __restrict__ sA, int ssA, int Mlim,
                 const bf16_t* __restrict__ B, int ldb, const float* __restrict__ sB, int ssB, int Nlim,
                 int K, f32x4 (&acc)[4][4], bf16_t* lA, bf16_t* lB) {
  uint4 ra[4], rb[4];
  tile_load<TRA>(A, lda, sA, ssA, Mlim, 0, ra);
  tile_load<TRB>(B, ldb, sB, ssB, Nlim, 0, rb);
  const int lane = threadIdx.x & 63, w = threadIdx.x >> 6, wm = w >> 1, wn = w & 1;
  const bf16_t* pa = lA + (wm * 64 + (lane & 15)) * LDK + (lane >> 4) * 8;
  const bf16_t* pb = lB + (wn * 64 + (lane & 15)) * LDK + (lane >> 4) * 8;
  for (int k0 = 0; k0 < K; k0 += 64) {
    __syncthreads();
    tile_store<TRA>(lA, ra);
    tile_store<TRB>(lB, rb);
    __syncthreads();
    if (k0 + 64 < K) {
      tile_load<TRA>(A, lda, sA, ssA, Mlim, k0 + 64, ra);
      tile_load<TRB>(B, ldb, sB, ssB, Nlim, k0 + 64, rb);
    }
    __builtin_amdgcn_s_setprio(1);
#pragma unroll 1
    for (int ks = 0; ks < 2; ++ks) {
      bf16x8 a[4], b[4];
#pragma unroll
      for (int t = 0; t < 4; ++t) {
        a[t] = *(const bf16x8*)(pa + t * 16 * LDK + ks * 32);
        b[t] = *(const bf16x8*)(pb + t * 16 * LDK + ks * 32);
      }
#pragma unroll
      for (int tm = 0; tm < 4; ++tm)
#pragma unroll
        for (int tn = 0; tn < 4; ++tn)
          acc[tm][tn] = __builtin_amdgcn_mfma_f32_16x16x32_bf16(a[tm], b[tn], acc[tm][tn], 0, 0, 0);
    }
    __builtin_amdgcn_s_setprio(0);
  }
}

DI void zero_acc(f32x4 (&acc)[4][4]) {
#pragma unroll
  for (int i = 0; i < 4; ++i)
#pragma unroll
    for (int j = 0; j < 4; ++j) acc[i][j] = f32x4{0.f, 0.f, 0.f, 0.f};
}

constexpr int LDK2 = 40;
DI void zero_acc8(f32x4 (&acc)[8][4]) {
#pragma unroll
  for (int i = 0; i < 8; ++i)
#pragma unroll
    for (int j = 0; j < 4; ++j) acc[i][j] = f32x4{0.f, 0.f, 0.f, 0.f};
}
DI void gemm256(const bf16_t* __restrict__ A, int lda, const bf16_t* __restrict__ B, int ldb, int K,
                f32x4 (&acc)[8][4], bf16_t* lA, bf16_t* lB) {
  const int tid = threadIdx.x;
  const int lrow = tid >> 2, kc = tid & 3;
  const bf16_t* ga = A + (size_t)lrow * lda + kc * 8;
  const bf16_t* gb = B + (size_t)lrow * ldb + kc * 8;
  const size_t sa = (size_t)64 * lda, sb = (size_t)64 * ldb;
  uint4 ra0 = *(const uint4*)(ga), ra1 = *(const uint4*)(ga + sa), ra2 = *(const uint4*)(ga + 2 * sa), ra3 = *(const uint4*)(ga + 3 * sa);
  uint4 rb0 = *(const uint4*)(gb), rb1 = *(const uint4*)(gb + sb);
  const int lane = tid & 63, w = tid >> 6, wm = w >> 1, wn = w & 1;
  const bf16_t* pa = lA + (wm * 128 + (lane & 15)) * LDK2 + (lane >> 4) * 8;
  const bf16_t* pb = lB + (wn * 64 + (lane & 15)) * LDK2 + (lane >> 4) * 8;
  bf16_t* wa = lA + lrow * LDK2 + kc * 8;
  bf16_t* wb = lB + lrow * LDK2 + kc * 8;
  for (int k0 = 0; k0 < K; k0 += 32) {
    __syncthreads();
    *(uint4*)(wa) = ra0; *(uint4*)(wa + 64 * LDK2) = ra1; *(uint4*)(wa + 128 * LDK2) = ra2; *(uint4*)(wa + 192 * LDK2) = ra3;
    *(uint4*)(wb) = rb0; *(uint4*)(wb + 64 * LDK2) = rb1;
    __syncthreads();
    if (k0 + 32 < K) {
      ga += 32; gb += 32;
      ra0 = *(const uint4*)(ga); ra1 = *(const uint4*)(ga + sa); ra2 = *(const uint4*)(ga + 2 * sa); ra3 = *(const uint4*)(ga + 3 * sa);
      rb0 = *(const uint4*)(gb); rb1 = *(const uint4*)(gb + sb);
    }
    __builtin_amdgcn_s_setprio(1);
    bf16x8 b[4];
#pragma unroll
    for (int t = 0; t < 4; ++t) b[t] = *(const bf16x8*)(pb + t * 16 * LDK2);
#pragma unroll
    for (int hf = 0; hf < 2; ++hf) {
      bf16x8 a[4];
#pragma unroll
      for (int t = 0; t < 4; ++t) a[t] = *(const bf16x8*)(pa + (hf * 4 + t) * 16 * LDK2);
#pragma unroll
      for (int tm = 0; tm < 4; ++tm)
#pragma unroll
        for (int tn = 0; tn < 4; ++tn)
          acc[hf * 4 + tm][tn] = __builtin_amdgcn_mfma_f32_16x16x32_bf16(a[tm], b[tn], acc[hf * 4 + tm][tn], 0, 0, 0);
    }
    __builtin_amdgcn_s_setprio(0);
  }
}

DI int xcd_tile(int it, int n) { return (it & 7) * (n >> 3) + (it >> 3); }

DI void wconv_tile(const float* __restrict__ W0, const float* __restrict__ W1, int type, int Kdim, int Nsrc,
                   int kt, int nt, bf16_t* __restrict__ out, float* tile) {
  const int tid = threadIdx.x;
  const int k0 = kt * 64, n0 = nt * 64;
  const int c4 = tid & 15, r = tid >> 4;
  const int np = n0 + c4 * 4;
  const float* src = W0;
  int col = np;
  bool valid = true;
  if (type == 0) {
    valid = np < Nsrc;
  } else if (type == 1) {
    const int q = np >> 5, rr = np & 31;
    src = rr < 16 ? W0 : W1;
    col = q * 16 + (rr & 15);
  } else if (type == 2) {
    valid = np < Nsrc;
    if (np < 640) {
      const int head = np >> 6, pp = np & 63, nb = pp >> 4, c = pp & 15;
      const int o = (nb == 0 ? 0 : nb == 1 ? 32 : nb == 2 ? 16 : 48) + c;
      col = head * 64 + o;
    }
  } else {
    if (np < 2048) {
      const int head = np >> 8, pp = np & 255, g = pp >> 5, rr = pp & 31;
      const int o = rr < 16 ? g * 16 + rr : 128 + g * 16 + (rr - 16);
      col = head * 256 + o;
    }
  }
  __syncthreads();
#pragma unroll
  for (int pass = 0; pass < 4; ++pass) {
    const int k = r + pass * 16;
    float4 v = make_float4(0.f, 0.f, 0.f, 0.f);
    if (valid) {
      const float* wp = src + (size_t)(k0 + k) * Nsrc + col;
      v.x = __builtin_nontemporal_load(wp); v.y = __builtin_nontemporal_load(wp + 1);
      v.z = __builtin_nontemporal_load(wp + 2); v.w = __builtin_nontemporal_load(wp + 3);
    }
    float* t = tile + k * 65 + c4 * 4;
    t[0] = v.x; t[1] = v.y; t[2] = v.z; t[3] = v.w;
  }
  __syncthreads();
  const int nn = tid >> 2, kp = tid & 3;
  const float* t = tile + (kp * 16) * 65 + nn;
  uint4 o0, o1;
  o0.x = pack2(t[0 * 65], t[1 * 65]); o0.y = pack2(t[2 * 65], t[3 * 65]);
  o0.z = pack2(t[4 * 65], t[5 * 65]); o0.w = pack2(t[6 * 65], t[7 * 65]);
  o1.x = pack2(t[8 * 65], t[9 * 65]); o1.y = pack2(t[10 * 65], t[11 * 65]);
  o1.z = pack2(t[12 * 65], t[13 * 65]); o1.w = pack2(t[14 * 65], t[15 * 65]);
  uint4* dst = (uint4*)(out + (size_t)(n0 + nn) * Kdim + k0 + kp * 16);
  dst[0] = o0; dst[1] = o1;
}

DI void phase0(const Params& p, unsigned char* smem) {
  unsigned char* ws = p.ws;
  float* tile = (float*)smem;
  constexpr int T0 = 16 * 34, T1 = 16 * 16, T2 = 16 * 88, T3 = 44 * 16, T4 = 16 * 96, T5 = 32 * 16, T6 = T2, T7 = T3;
  constexpr int S1 = T0, S2 = S1 + T1, S3 = S2 + T2, S4 = S3 + T3, S5 = S4 + T4, S6 = S5 + T5, S7 = S6 + T6, S8 = S7 + T7;
  constexpr int NMOD = 192, NSC1 = 256, NCACHE = 512;
  constexpr int E1 = S8 + NMOD, E2 = E1 + NSC1, E3 = E2 + NCACHE, E4 = E3 + 20;
  const int tid = threadIdx.x;
  for (int it = blockIdx.x; it < E4; it += p.gsz) {
    if (it < S8) {
      if (it < S1) { int i = it; wconv_tile(p.in[12], nullptr, 2, 1024, 2064, i / 34, i % 34, (bf16_t*)(ws + OFF_WIN0), tile); }
      else if (it < S2) { int i = it - S1; wconv_tile(p.in[13], nullptr, 0, 1024, 1024, i / 16, i % 16, (bf16_t*)(ws + OFF_WOUT0), tile); }
      else if (it < S3) { int i = it - S2; wconv_tile(p.in[22], p.in[23], 1, 1024, 2816, i / 88, i % 88, (bf16_t*)(ws + OFF_WGU0), tile); }
      else if (it < S4) { int i = it - S3; wconv_tile(p.in[24], nullptr, 0, 2816, 1024, i / 16, i % 16, (bf16_t*)(ws + OFF_WDN0), tile); }
      else if (it < S5) { int i = it - S4; wconv_tile(p.in[29], nullptr, 3, 1024, 6144, i / 96, i % 96, (bf16_t*)(ws + OFF_WIN1), tile); }
      else if (it < S6) { int i = it - S5; wconv_tile(p.in[30], nullptr, 0, 2048, 1024, i / 16, i % 16, (bf16_t*)(ws + OFF_WOUT1), tile); }
      else if (it < S7) { int i = it - S6; wconv_tile(p.in[33], p.in[34], 1, 1024, 2816, i / 88, i % 88, (bf16_t*)(ws + OFF_WGU1), tile); }
      else { int i = it - S7; wconv_tile(p.in[35], nullptr, 0, 2816, 1024, i / 16, i % 16, (bf16_t*)(ws + OFF_WDN1), tile); }
    } else if (it < E1) {
      const int i = it - S8, layer = i / 96, cgp = i % 96;
      const float* wada = p.in[layer ? 25 : 8];
      const float* bada = p.in[layer ? 26 : 9];
      float* scond = (float*)smem;
      float* red = scond + 3072;
      __syncthreads();
      for (int e = tid; e < 3072; e += 256) {
        const int r = e >> 10, k = e & 1023;
        const float cv = (r == 0) ? p.in[7][k] : p.in[2][(r - 1) * 1024 + k];
        scond[e] = siluf(cv);
      }
      __syncthreads();
      const int n = cgp * 64 + (tid & 63), kq = tid >> 6;
      float a0 = 0.f, a1 = 0.f, a2 = 0.f;
#pragma unroll 8
      for (int k = kq * 256; k < kq * 256 + 256; ++k) {
        const float wv = __builtin_nontemporal_load(wada + (size_t)k * 6144 + n);
        a0 += scond[k] * wv; a1 += scond[1024 + k] * wv; a2 += scond[2048 + k] * wv;
      }
      red[(kq * 3 + 0) * 64 + (tid & 63)] = a0;
      red[(kq * 3 + 1) * 64 + (tid & 63)] = a1;
      red[(kq * 3 + 2) * 64 + (tid & 63)] = a2;
      __syncthreads();
      if (tid < 192) {
        const int r = tid >> 6, c = tid & 63;
        const float s = red[(0 * 3 + r) * 64 + c] + red[(1 * 3 + r) * 64 + c] + red[(2 * 3 + r) * 64 + c] + red[(3 * 3 + r) * 64 + c];
        float* mod = (float*)(ws + OFF_MOD);
        mod[(layer * 3 + r) * 6144 + cgp * 64 + c] = s + bada[cgp * 64 + c];
      }
    } else if (it < E2) {
      const int e = (it - E1) * 256 + tid;
      const int tok = e >> 2, h = e & 3;
      const int il = tok & 255;
      const float lgf = -__expf(p.in[31][h]), lgb = -__expf(p.in[31][4 + h]);
      float* sc = (float*)(ws + OFF_SC1);
      const size_t NS = (size_t)NTOK * 4;
      sc[0 * NS + e] = __expf((il + 1) * lgf);
      sc[1 * NS + e] = __expf((256 - il) * lgb);
      sc[2 * NS + e] = __expf((255 - il) * lgf);
      sc[3 * NS + e] = __expf(il * lgb);
      sc[4 * NS + e] = (il + 1) * lgf;
      sc[5 * NS + e] = (256 - il) * lgb;
      sc[6 * NS + e] = 1.f;
      sc[7 * NS + e] = 1.f;
    } else if (it >= E3) {
      const int i = it - E3;
      float sn, cs;
      if (i < 4) {
        const int e = i * 256 + tid, pos = e >> 4, f = e & 15;
        sincos_rev((float)pos * exp2f(-(float)f * (13.287712379549449f / 16.f)), sn, cs);
        ((float2*)(ws + OFF_ROPE0))[e] = make_float2(cs, sn);
      } else {
        const int e = (i - 4) * 256 + tid, pos = e >> 6, f = e & 63;
        sincos_rev((float)pos * exp2f(-(float)f * (13.287712379549449f / 64.f)), sn, cs);
        ((float2*)(ws + OFF_ROPE1))[e] = make_float2(cs, sn);
      }
    } else {
      const int i = it - E2;
      const int isv = i >> 8;
      const int e = (i & 255) * 256 + tid;
      const int b = e >> 15, rem = e & 32767;
      const float v = p.in[isv ? 4 : 3][e];
      bf16_t* dst = (bf16_t*)(ws + (isv ? OFF_VL : OFF_KL));
      dst[(size_t)b * 4352 * 128 + rem] = f2bf(v);
    }
  }
}

DI void phase_normmod(const Params& p, const float* xsrc, const float* gain, int layer, int shift_idx, int scale_idx) {
  const int lane = threadIdx.x & 63, w = threadIdx.x >> 6;
  bf16_t* H = (bf16_t*)(p.ws + OFF_H);
  const float* mod = (const float*)(p.ws + OFF_MOD) + (size_t)layer * 3 * 6144;
  for (int tok = (blockIdx.x * 4 + w) * 2; tok < NTOK; tok += p.gsz * 8) {
    float4 v[2][4];
#pragma unroll
    for (int r = 0; r < 2; ++r) {
      const float* xr = xsrc ? xsrc + (size_t)(tok + r) * DM : xin_row(p, tok + r);
#pragma unroll
      for (int i = 0; i < 4; ++i) v[r][i] = *(const float4*)(xr + i * 256 + lane * 4);
    }
    const int cr = cond_row(tok);
    const float* sh = mod + cr * 6144 + shift_idx * 1024;
    const float* sc = mod + cr * 6144 + scale_idx * 1024;
    float rinv[2];
#pragma unroll
    for (int r = 0; r < 2; ++r) {
      float ss = 0.f;
#pragma unroll
      for (int i = 0; i < 4; ++i) ss += v[r][i].x * v[r][i].x + v[r][i].y * v[r][i].y + v[r][i].z * v[r][i].z + v[r][i].w * v[r][i].w;
      ss = wave_sum(ss);
      rinv[r] = rsqrtf(ss * (1.f / 1024.f) + EPSF);
    }
#pragma unroll
    for (int i = 0; i < 4; ++i) {
      const int col = i * 256 + lane * 4;
      const float4 g = *(const float4*)(gain + col);
      const float4 s1 = *(const float4*)(sc + col);
      const float4 s0 = *(const float4*)(sh + col);
#pragma unroll
      for (int r = 0; r < 2; ++r) {
        const float o0 = v[r][i].x * rinv[r] * g.x * (1.f + s1.x) + s0.x;
        const float o1 = v[r][i].y * rinv[r] * g.y * (1.f + s1.y) + s0.y;
        const float o2 = v[r][i].z * rinv[r] * g.z * (1.f + s1.z) + s0.z;
        const float o3 = v[r][i].w * rinv[r] * g.w * (1.f + s1.w) + s0.w;
        uint2 pk; pk.x = pack2(o0, o1); pk.y = pack2(o2, o3);
        *(uint2*)(H + (size_t)(tok + r) * DM + col) = pk;
      }
    }
  }
}

DI void phase_l0_inproj(const Params& p, unsigned char* smem) {
  unsigned char* ws = p.ws;
  bf16_t* lA = (bf16_t*)smem; bf16_t* lB = lA + 128 * LDK;
  const bf16_t* H = (const bf16_t*)(ws + OFF_H);
  const bf16_t* W = (const bf16_t*)(ws + OFF_WIN0);
  const int lane = threadIdx.x & 63, w = threadIdx.x >> 6, wm = w >> 1, wn = w & 1;
  const int c = lane & 15;
  bf16_t* Q0 = (bf16_t*)(ws + OFF_Q0);
  bf16_t* Kc = (bf16_t*)(ws + OFF_KC); bf16_t* Vc = (bf16_t*)(ws + OFF_VC);
  bf16_t* Kl = (bf16_t*)(ws + OFF_KL); bf16_t* Vl = (bf16_t*)(ws + OFF_VL);
  bf16_t* Zs = (bf16_t*)(ws + OFF_ZS);
  float* XBC = (float*)(ws + OFF_XBC); float* DT = (float*)(ws + OFF_DT);
  const float2* rope0 = (const float2*)(ws + OFF_ROPE0);
  for (int it = blockIdx.x; it < 128 * 17; it += p.gsz) {
    const int tl_ = xcd_tile(it, 128 * 17); const int rt = tl_ / 17, ct = tl_ % 17;
    f32x4 acc[4][4];
    zero_acc(acc);
    gemm_seg<false, false>(H + (size_t)rt * 128 * DM, DM, nullptr, 0, 128, W + (size_t)ct * 128 * DM, DM, nullptr, 0, 128, DM, acc, lA, lB);
    const int row0 = rt * 128 + wm * 64, col0 = ct * 128 + wn * 64;
    if (col0 < 640) {
      const bool isq = col0 < 512;
      const int head = isq ? (col0 >> 6) : ((col0 - 512) >> 6);
      const float* gain = p.in[isq ? 14 : 15];
      const float g0 = gain[c], g1 = gain[32 + c], g2 = gain[16 + c], g3 = gain[48 + c];
#pragma unroll
      for (int tm = 0; tm < 4; ++tm)
#pragma unroll
        for (int j = 0; j < 4; ++j) {
          const int tok = row0 + tm * 16 + (lane >> 4) * 4 + j;
          float v0 = acc[tm][0][j], v1 = acc[tm][1][j], v2 = acc[tm][2][j], v3 = acc[tm][3][j];
          float ss = v0 * v0 + v1 * v1 + v2 * v2 + v3 * v3;
          ss = sum16(ss);
          const float rinv = rsqrtf(ss * (1.f / 64.f) + EPSF);
          v0 *= rinv * g0; v1 *= rinv * g1; v2 *= rinv * g2; v3 *= rinv * g3;
          if (tok < NCTX) {
            if (isq) {
              bf16_t* d = Q0 + (size_t)tok * 512 + head * 64;
              d[c] = f2bf(v0); d[32 + c] = f2bf(v1); d[16 + c] = f2bf(v2); d[48 + c] = f2bf(v3);
            } else {
              float* o = p.out + OUT_K0 + (size_t)tok * 128 + head * 64;
              o[c] = v0; o[32 + c] = v1; o[16 + c] = v2; o[48 + c] = v3;
              bf16_t* d = Kc + (size_t)tok * 128 + head * 64;
              d[c] = f2bf(v0); d[32 + c] = f2bf(v1); d[16 + c] = f2bf(v2); d[48 + c] = f2bf(v3);
            }
          } else {
            const int u = tok - NCTX, tl = u & 4095, b = u >> 12;
            const float2 t0 = rope0[(tl >> 6) * 16 + c], t1 = rope0[(tl & 63) * 16 + c];
            const float c0 = t0.x, s0 = t0.y, c1 = t1.x, s1 = t1.y;
            const float a0 = v0 * c0 - v1 * s0, a1 = v1 * c0 + v0 * s0;
            const float a2 = v2 * c1 - v3 * s1, a3 = v3 * c1 + v2 * s1;
            bf16_t* d = isq ? (Q0 + (size_t)tok * 512 + head * 64)
                            : (Kl + ((size_t)b * 4352 + 256 + tl) * 128 + head * 64);
            d[c] = f2bf(a0); d[32 + c] = f2bf(a1); d[16 + c] = f2bf(a2); d[48 + c] = f2bf(a3);
          }
        }
    } else if (col0 < 768) {
      const int kv = (col0 - 640) >> 6;
#pragma unroll
      for (int tm = 0; tm < 4; ++tm)
#pragma unroll
        for (int j = 0; j < 4; ++j) {
          const int tok = row0 + tm * 16 + (lane >> 4) * 4 + j;
#pragma unroll
          for (int tn = 0; tn < 4; ++tn) {
            const float v = acc[tm][tn][j];
            const int o = kv * 64 + tn * 16 + c;
            if (tok < NCTX) {
              p.out[OUT_V0 + (size_t)tok * 128 + o] = v;
              Vc[(size_t)tok * 128 + o] = f2bf(v);
            } else {
              const int u = tok - NCTX, tl = u & 4095, b = u >> 12;
              Vl[((size_t)b * 4352 + 256 + tl) * 128 + o] = f2bf(v);
            }
          }
        }
    } else if (col0 < 1280) {
#pragma unroll
      for (int tm = 0; tm < 4; ++tm)
#pragma unroll
        for (int j = 0; j < 4; ++j) {
          const int tok = row0 + tm * 16 + (lane >> 4) * 4 + j;
#pragma unroll
          for (int tn = 0; tn < 4; ++tn)
            Zs[(size_t)tok * 512 + (col0 - 768) + tn * 16 + c] = f2bf(siluf(acc[tm][tn][j]));
        }
    } else if (col0 < 2048) {
#pragma unroll
      for (int tm = 0; tm < 4; ++tm)
#pragma unroll
        for (int j = 0; j < 4; ++j) {
          const int tok = row0 + tm * 16 + (lane >> 4) * 4 + j;
#pragma unroll
          for (int tn = 0; tn < 4; ++tn)
            XBC[(size_t)tok * 768 + (col0 - 1280) + tn * 16 + c] = acc[tm][tn][j];
        }
    } else if (col0 == 2048) {
#pragma unroll
      for (int tm = 0; tm < 4; ++tm)
#pragma unroll
        for (int j = 0; j < 4; ++j) {
          const int tok = row0 + tm * 16 + (lane >> 4) * 4 + j;
          DT[(size_t)tok * 16 + c] = acc[tm][0][j];
        }
    }
  }
}

constexpr int ALD = 72;
DI void attn_item(const Params& p, int item, unsigned char* smem) {
  unsigned char* ws = p.ws;
  bf16_t* sK = (bf16_t*)smem;
  bf16_t* sVt = sK + 64 * ALD;
  bf16_t* sP = sVt + 64 * ALD;
  const int tid = threadIdx.x, lane = tid & 63, w = tid >> 6;
  int b, hq, qb, tok0, nkeys;
  const bf16_t *Kb, *Vb;
  if (item < 512) {
    qb = item & 31; hq = (item >> 5) & 7; b = item >> 8;
    tok0 = NCTX + b * 4096 + qb * 128; nkeys = 4352;
    Kb = (const bf16_t*)(ws + OFF_KL) + (size_t)b * 4352 * 128;
    Vb = (const bf16_t*)(ws + OFF_VL) + (size_t)b * 4352 * 128;
  } else {
    const int i = item - 512;
    qb = i & 1; hq = (i >> 1) & 7; b = i >> 4;
    tok0 = b * 256 + qb * 128; nkeys = 256;
    Kb = (const bf16_t*)(ws + OFF_KC) + (size_t)b * 256 * 128;
    Vb = (const bf16_t*)(ws + OFF_VC) + (size_t)b * 256 * 128;
  }
  const int kv = hq >> 2;
  Kb += kv * 64; Vb += kv * 64;
  const bf16_t* Q0 = (const bf16_t*)(ws + OFF_Q0);
  const int g4 = lane >> 4, ln = lane & 15;
  bf16x8 qf[2][2];
#pragma unroll
  for (int qb = 0; qb < 2; ++qb)
#pragma unroll
    for (int ks = 0; ks < 2; ++ks)
      qf[qb][ks] = *(const bf16x8*)(Q0 + (size_t)(tok0 + w * 32 + qb * 16 + ln) * 512 + hq * 64 + ks * 32 + g4 * 8);
  f32x4 O[4][2];
  float m[2], l[2];
#pragma unroll
  for (int qb = 0; qb < 2; ++qb) {
#pragma unroll
    for (int d = 0; d < 4; ++d) O[d][qb] = f32x4{0.f, 0.f, 0.f, 0.f};
    m[qb] = -1e30f; l[qb] = 0.f;
  }
  const int nt = nkeys >> 6;
  const int key0 = tid >> 3, key1 = (tid + 256) >> 3, dc0 = tid & 7;
  uint4 rk0 = *(const uint4*)(Kb + (size_t)key0 * 128 + dc0 * 8);
  uint4 rk1 = *(const uint4*)(Kb + (size_t)key1 * 128 + dc0 * 8);
  const int vkey = tid & 63, vdc0 = tid >> 6, vdc1 = vdc0 + 4;
  uint4 rv0 = *(const uint4*)(Vb + (size_t)vkey * 128 + vdc0 * 8);
  uint4 rv1 = *(const uint4*)(Vb + (size_t)vkey * 128 + vdc1 * 8);
  for (int kt = 0; kt < nt; ++kt) {
    __syncthreads();
    *(uint4*)(sK + key0 * ALD + dc0 * 8) = rk0;
    *(uint4*)(sK + key1 * ALD + dc0 * 8) = rk1;
    {
      bf16_t* q = sVt + (vdc0 * 8) * ALD + vkey;
      q[0 * ALD] = (bf16_t)(rv0.x & 0xffffu); q[1 * ALD] = (bf16_t)(rv0.x >> 16);
      q[2 * ALD] = (bf16_t)(rv0.y & 0xffffu); q[3 * ALD] = (bf16_t)(rv0.y >> 16);
      q[4 * ALD] = (bf16_t)(rv0.z & 0xffffu); q[5 * ALD] = (bf16_t)(rv0.z >> 16);
      q[6 * ALD] = (bf16_t)(rv0.w & 0xffffu); q[7 * ALD] = (bf16_t)(rv0.w >> 16);
      q = sVt + (vdc1 * 8) * ALD + vkey;
      q[0 * ALD] = (bf16_t)(rv1.x & 0xffffu); q[1 * ALD] = (bf16_t)(rv1.x >> 16);
      q[2 * ALD] = (bf16_t)(rv1.y & 0xffffu); q[3 * ALD] = (bf16_t)(rv1.y >> 16);
      q[4 * ALD] = (bf16_t)(rv1.z & 0xffffu); q[5 * ALD] = (bf16_t)(rv1.z >> 16);
      q[6 * ALD] = (bf16_t)(rv1.w & 0xffffu); q[7 * ALD] = (bf16_t)(rv1.w >> 16);
    }
    __syncthreads();
    if (kt + 1 < nt) {
      const size_t kbase = (size_t)(kt + 1) * 64;
      rk0 = *(const uint4*)(Kb + (kbase + key0) * 128 + dc0 * 8);
      rk1 = *(const uint4*)(Kb + (kbase + key1) * 128 + dc0 * 8);
      rv0 = *(const uint4*)(Vb + (kbase + vkey) * 128 + vdc0 * 8);
      rv1 = *(const uint4*)(Vb + (kbase + vkey) * 128 + vdc1 * 8);
    }
    f32x4 s[4][2];
    __builtin_amdgcn_s_setprio(1);
#pragma unroll
    for (int kb = 0; kb < 4; ++kb) {
      const bf16x8 k0 = *(const bf16x8*)(sK + (kb * 16 + ln) * ALD + g4 * 8);
      const bf16x8 k1 = *(const bf16x8*)(sK + (kb * 16 + ln) * ALD + 32 + g4 * 8);
#pragma unroll
      for (int qb = 0; qb < 2; ++qb) {
        f32x4 z = f32x4{0.f, 0.f, 0.f, 0.f};
        z = __builtin_amdgcn_mfma_f32_16x16x32_bf16(k0, qf[qb][0], z, 0, 0, 0);
        z = __builtin_amdgcn_mfma_f32_16x16x32_bf16(k1, qf[qb][1], z, 0, 0, 0);
        s[kb][qb] = z;
      }
    }
    __builtin_amdgcn_s_setprio(0);
#pragma unroll
    for (int qb = 0; qb < 2; ++qb) {
      float mx = -1e30f;
#pragma unroll
      for (int kb = 0; kb < 4; ++kb)
        mx = fmaxf(mx, fmaxf(fmaxf(s[kb][qb][0], s[kb][qb][1]), fmaxf(s[kb][qb][2], s[kb][qb][3])));
      mx *= 0.18033688011112042f;
      mx = fmaxf(mx, __shfl_xor(mx, 16, 64));
      mx = fmaxf(mx, __shfl_xor(mx, 32, 64));
      const float mn = fmaxf(m[qb], mx);
      const float alpha = __builtin_amdgcn_exp2f(m[qb] - mn);
      m[qb] = mn;
      float rs = 0.f;
#pragma unroll
      for (int kb = 0; kb < 4; ++kb)
#pragma unroll
        for (int j = 0; j < 4; ++j) {
          const float pv = __builtin_amdgcn_exp2f(s[kb][qb][j] * 0.18033688011112042f - mn);
          rs += pv;
          s[kb][qb][j] = pv;
        }
      l[qb] = l[qb] * alpha + rs;
#pragma unroll
      for (int d = 0; d < 4; ++d) {
        O[d][qb][0] *= alpha; O[d][qb][1] *= alpha; O[d][qb][2] *= alpha; O[d][qb][3] *= alpha;
      }
    }
    __builtin_amdgcn_s_setprio(1);
#pragma unroll
    for (int ksp = 0; ksp < 2; ++ksp) {
      bf16x8 pb[2];
#pragma unroll
      for (int qb = 0; qb < 2; ++qb) {
        uint4 u;
        u.x = pack2(s[2 * ksp][qb][0], s[2 * ksp][qb][1]); u.y = pack2(s[2 * ksp][qb][2], s[2 * ksp][qb][3]);
        u.z = pack2(s[2 * ksp + 1][qb][0], s[2 * ksp + 1][qb][1]); u.w = pack2(s[2 * ksp + 1][qb][2], s[2 * ksp + 1][qb][3]);
        pb[qb] = __builtin_bit_cast(bf16x8, u);
      }
#pragma unroll
      for (int d = 0; d < 4; ++d) {
        const bf16_t* vp = sVt + (d * 16 + ln) * ALD + 32 * ksp + 4 * g4;
        uint4 u;
        const uint2 lo = *(const uint2*)vp, hi = *(const uint2*)(vp + 16);
        u.x = lo.x; u.y = lo.y; u.z = hi.x; u.w = hi.y;
        const bf16x8 va = __builtin_bit_cast(bf16x8, u);
#pragma unroll
        for (int qb = 0; qb < 2; ++qb)
          O[d][qb] = __builtin_amdgcn_mfma_f32_16x16x32_bf16(va, pb[qb], O[d][qb], 0, 0, 0);
      }
    }
    __builtin_amdgcn_s_setprio(0);
  }
  bf16_t* Aout = (bf16_t*)(ws + OFF_AOUT);
#pragma unroll
  for (int qb = 0; qb < 2; ++qb) {
    float lt = l[qb];
    lt += __shfl_xor(lt, 16, 64);
    lt += __shfl_xor(lt, 32, 64);
    const float inv = 1.f / lt;
    const int tok = tok0 + w * 32 + qb * 16 + ln;
#pragma unroll
    for (int d = 0; d < 4; ++d) {
      uint2 pk;
      pk.x = pack2(O[d][qb][0] * inv, O[d][qb][1] * inv);
      pk.y = pack2(O[d][qb][2] * inv, O[d][qb][3] * inv);
      *(uint2*)(Aout + (size_t)tok * DM + hq * 64 + d * 16 + g4 * 4) = pk;
    }
  }
}

template <class F>
DI void conv_run(const float* XBC, const float* cw, const float* cbias, int col, int tbeg, int seq_lo, int seq_hi, F&& emit) {
  const float w0 = cw[0 * 768 + col], w1 = cw[1 * 768 + col], w2 = cw[2 * 768 + col], w3 = cw[3 * 768 + col], w4 = cw[4 * 768 + col];
  const float bias = cbias[col];
  float xm2 = (tbeg - 2 >= seq_lo) ? XBC[(size_t)(tbeg - 2) * 768 + col] : 0.f;
  float xm1 = (tbeg - 1 >= seq_lo) ? XBC[(size_t)(tbeg - 1) * 768 + col] : 0.f;
  float x0 = XBC[(size_t)tbeg * 768 + col];
  float xp1 = (tbeg + 1 < seq_hi) ? XBC[(size_t)(tbeg + 1) * 768 + col] : 0.f;
#pragma unroll 1
  for (int t16 = 0; t16 < 64; t16 += 16) {
    float xn[16];
#pragma unroll
    for (int i = 0; i < 16; ++i) {
      const int tk = tbeg + t16 + i + 2;
      xn[i] = (tk < seq_hi) ? XBC[(size_t)tk * 768 + col] : 0.f;
    }
#pragma unroll
    for (int hf = 0; hf < 2; ++hf) {
      float y[8];
#pragma unroll
      for (int i = 0; i < 8; ++i) {
        y[i] = siluf(bias + xm2 * w0 + xm1 * w1 + x0 * w2 + xp1 * w3 + xn[hf * 8 + i] * w4);
        xm2 = xm1; xm1 = x0; x0 = xp1; xp1 = xn[hf * 8 + i];
      }
      emit(tbeg + t16 + hf * 8, y);
    }
  }
}
DI uint4 pack8(const float (&y)[8]) {
  uint4 u; u.x = pack2(y[0], y[1]); u.y = pack2(y[2], y[3]); u.z = pack2(y[4], y[5]); u.w = pack2(y[6], y[7]);
  return u;
}

DI void ssd_prep_item(const Params& p, int item, unsigned char* smem) {
  unsigned char* ws = p.ws;
  const int tid = threadIdx.x;
  const int c = item / 10, u = item % 10, tok0 = c * 256;
  int seq_lo, seq_hi;
  if (c < 32) { seq_lo = tok0; seq_hi = tok0 + 256; }
  else { const int b = (c - 32) >> 4; seq_lo = NCTX + b * 4096; seq_hi = seq_lo + 4096; }
  const float* XBC = (const float*)(ws + OFF_XBC);
  const float* cw = p.in[16];
  const float* cbias = p.in[17];
  const int chl = tid & 63, tg = tid >> 6;
  const int tbeg = tok0 + tg * 64;
  if (u < 8) {
    const int h = u, g = h >> 2;
    float* sf = (float*)smem;
    float* sb = sf + 256;
    const float* DT = (const float*)(ws + OFF_DT);
    float dtv[2], av[2];
#pragma unroll
    for (int dir = 0; dir < 2; ++dir) {
      const float raw = DT[(size_t)(tok0 + tid) * 16 + dir * 8 + h] + p.in[18][dir * 8 + h];
      const float sp = fmaxf(raw, 0.f) + log1pf(__expf(-fabsf(raw)));
      dtv[dir] = sp;
      av[dir] = -sp * __expf(p.in[19][dir * 8 + h]);
    }
    __syncthreads();
    sf[tid] = av[0]; sb[tid] = av[1];
    __syncthreads();
    for (int off = 1; off < 256; off <<= 1) {
      const float vf = sf[tid] + (tid >= off ? sf[tid - off] : 0.f);
      const float vb = sb[tid] + (tid + off < 256 ? sb[tid + off] : 0.f);
      __syncthreads();
      sf[tid] = vf; sb[tid] = vb;
      __syncthreads();
    }
    const float cf = sf[tid], cb = sb[tid], totf = sf[255], totb = sb[0];
    float* sc = (float*)(ws + OFF_SC0);
    const size_t NS = (size_t)NTOK * 8;
    const size_t e = (size_t)(tok0 + tid) * 8 + h;
    const float wfv = dtv[0] * __expf(totf - cf), wbv = dtv[1] * __expf(totb - cb);
    sc[0 * NS + e] = __expf(cf);
    sc[1 * NS + e] = __expf(cb);
    sc[4 * NS + e] = cf;
    sc[5 * NS + e] = cb;
    sc[6 * NS + e] = dtv[0];
    sc[7 * NS + e] = dtv[1];
    __syncthreads();
    sf[tid] = wfv; sb[tid] = wbv;
    __syncthreads();
    {
      const int col = h * 64 + chl;
      float* XS = (float*)(ws + OFF_XS);
      bf16_t* VT = (bf16_t*)(ws + OFF_VS);
      conv_run(XBC, cw, cbias, col, tbeg, seq_lo, seq_hi, [&](int t, const float (&y)[8]) {
#pragma unroll
        for (int i = 0; i < 8; ++i) XS[(size_t)(t + i) * 512 + col] = y[i];
        *(uint4*)(VT + ((size_t)c * 512 + col) * 256 + (t - tok0)) = pack8(y);
      });
    }
    {
      const int col = 512 + g * 64 + chl;
      bf16_t* KT = (bf16_t*)(ws + OFF_SST1B);
      bf16_t* ktf = KT + ((size_t)((c * 2 + 0) * 8 + h) * 64 + chl) * 256;
      bf16_t* ktb = KT + ((size_t)((c * 2 + 1) * 8 + h) * 64 + chl) * 256;
      conv_run(XBC, cw, cbias, col, tbeg, seq_lo, seq_hi, [&](int t, const float (&y)[8]) {
        const int tl = t - tok0;
        float yf[8], yb[8];
#pragma unroll
        for (int i = 0; i < 8; ++i) { yf[i] = y[i] * sf[tl + i]; yb[i] = y[i] * sb[tl + i]; }
        *(uint4*)(ktf + tl) = pack8(yf);
        *(uint4*)(ktb + tl) = pack8(yb);
      });
    }
  } else {
    const int g = u - 8;
    bf16_t* BBp = (bf16_t*)(ws + OFF_BB);
    bf16_t* CCp = (bf16_t*)(ws + OFF_CC);
    conv_run(XBC, cw, cbias, 512 + g * 64 + chl, tbeg, seq_lo, seq_hi, [&](int t, const float (&y)[8]) {
#pragma unroll
      for (int i = 0; i < 8; ++i) BBp[(size_t)(t + i) * 128 + g * 64 + chl] = f2bf(y[i]);
    });
    conv_run(XBC, cw, cbias, 640 + g * 64 + chl, tbeg, seq_lo, seq_hi, [&](int t, const float (&y)[8]) {
#pragma unroll
      for (int i = 0; i < 8; ++i) CCp[(size_t)(t + i) * 128 + g * 64 + chl] = f2bf(y[i]);
    });
  }
}

DI void pgemm_tile(const bf16_t* Q, int ldq, const bf16_t* Kp, int ldk, int dk, const float* sc, int H, int h, int tok0,
                   int ti, int tj, bf16_t* Pout, unsigned char* smem) {
  bf16_t* lA = (bf16_t*)smem; bf16_t* lB = lA + 128 * LDK;
  const int lane = threadIdx.x & 63, w = threadIdx.x >> 6, wm = w >> 1, wn = w & 1;
  f32x4 acc[4][4];
  zero_acc(acc);
  gemm_seg<false, false>(Q + (size_t)(ti * 128) * ldq, ldq, nullptr, 0, 128, Kp + (size_t)(tj * 128) * ldk, ldk, nullptr, 0, 128, dk, acc, lA, lB);
  const size_t NS = (size_t)NTOK * H;
  const float* CUMF = sc + 4 * NS; const float* CUMB = sc + 5 * NS; const float* DTF = sc + 6 * NS; const float* DTB = sc + 7 * NS;
  float cfj[4], cbj[4], dfj[4], dbj[4];
#pragma unroll
  for (int tn = 0; tn < 4; ++tn) {
    const int jj = tj * 128 + wn * 64 + tn * 16 + (lane & 15);
    const size_t e = (size_t)(tok0 + jj) * H + h;
    cfj[tn] = CUMF[e]; cbj[tn] = CUMB[e]; dfj[tn] = DTF[e]; dbj[tn] = DTB[e];
  }
#pragma unroll
  for (int tm = 0; tm < 4; ++tm)
#pragma unroll
    for (int j = 0; j < 4; ++j) {
      const int i = ti * 128 + wm * 64 + tm * 16 + (lane >> 4) * 4 + j;
      const size_t e = (size_t)(tok0 + i) * H + h;
      const float cfi = CUMF[e], cbi = CUMB[e];
#pragma unroll
      for (int tn = 0; tn < 4; ++tn) {
        const int jj = tj * 128 + wn * 64 + tn * 16 + (lane & 15);
        float mk = 0.f;
        if (jj <= i) mk += __expf(cfi - cfj[tn]) * dfj[tn];
        if (jj >= i) mk += __expf(cbi - cbj[tn]) * dbj[tn];
        Pout[(size_t)i * 256 + jj] = f2bf(acc[tm][tn][j] * mk);
      }
    }
}

DI void dsgemm_tile(const bf16_t* Kp, int ldk, const float* wsc, int ss, const bf16_t* V, int ldv, int dk, int dv,
                    int tmi, int tni, float* out, unsigned char* smem) {
  bf16_t* lA = (bf16_t*)smem; bf16_t* lB = lA + 128 * LDK;
  const int lane = threadIdx.x & 63, w = threadIdx.x >> 6, wm = w >> 1, wn = w & 1;
  f32x4 acc[4][4];
  zero_acc(acc);
  const int Mlim = dk - tmi * 128 < 128 ? dk - tmi * 128 : 128;
  const int Nlim = dv - tni * 128 < 128 ? dv - tni * 128 : 128;
  gemm_seg<true, true>(Kp + tmi * 128, ldk, wsc, ss, Mlim, V + tni * 128, ldv, nullptr, 0, Nlim, 256, acc, lA, lB);
#pragma unroll
  for (int tm = 0; tm < 4; ++tm)
#pragma unroll
    for (int j = 0; j < 4; ++j) {
      const int d = tmi * 128 + wm * 64 + tm * 16 + (lane >> 4) * 4 + j;
#pragma unroll
      for (int tn = 0; tn < 4; ++tn) {
        const int e = tni * 128 + wn * 64 + tn * 16 + (lane & 15);
        if (d < dk && e < dv) out[(size_t)d * dv + e] = acc[tm][tn][j];
      }
    }
}

DI void dsgemm_nt_tile(const bf16_t* A, const bf16_t* B, int tmi, int tni, float* out, bf16_t* outb, int ldo, unsigned char* smem) {
  bf16_t* lA = (bf16_t*)smem; bf16_t* lB = lA + 128 * LDK;
  const int lane = threadIdx.x & 63, w = threadIdx.x >> 6, wm = w >> 1, wn = w & 1;
  f32x4 acc[4][4];
  zero_acc(acc);
  gemm_seg<false, false>(A + (size_t)tmi * 128 * 256, 256, nullptr, 0, 128, B + (size_t)tni * 128 * 256, 256, nullptr, 0, 128, 256, acc, lA, lB);
#pragma unroll
  for (int tm = 0; tm < 4; ++tm)
#pragma unroll
    for (int j = 0; j < 4; ++j) {
      const int r = tmi * 128 + wm * 64 + tm * 16 + (lane >> 4) * 4 + j;
#pragma unroll
      for (int tn = 0; tn < 4; ++tn) {
        const size_t o = (size_t)r * ldo + tni * 128 + wn * 64 + tn * 16 + (lane & 15);
        if (out) __builtin_nontemporal_store(acc[tm][tn][j], out + o);
        else outb[o] = f2bf(acc[tm][tn][j]);
      }
    }
}

DI void phase_ssd_pds(const Params& p, unsigned char* smem) {
  unsigned char* ws = p.ws;
  const bf16_t* CC = (const bf16_t*)(ws + OFF_CC);
  const bf16_t* BB = (const bf16_t*)(ws + OFF_BB);
  const bf16_t* VsT = (const bf16_t*)(ws + OFF_VS);
  const bf16_t* KT0 = (const bf16_t*)(ws + OFF_SST1B);
  const float* sc = (const float*)(ws + OFF_SC0);
  for (int it = blockIdx.x; it < 2048; it += p.gsz) {
    const int c = it >> 5, h = (it >> 2) & 7, ti = (it >> 1) & 1, tj = it & 1, g = h >> 2, tok0 = c * 256;
    pgemm_tile(CC + (size_t)tok0 * 128 + g * 64, 128, BB + (size_t)tok0 * 128 + g * 64, 128, 64, sc, 8, h, tok0, ti, tj,
               (bf16_t*)(ws + OFF_P0) + (size_t)(c * 8 + h) * 65536, smem);
  }
#pragma unroll 1
  for (int i = blockIdx.x; i < 1024; i += p.gsz) {
    const int c = i >> 4, h = (i >> 1) & 7, dir = i & 1;
    bf16_t* lA = (bf16_t*)smem; bf16_t* lB = lA + 128 * LDK;
    const int lane = threadIdx.x & 63, w = threadIdx.x >> 6;
    f32x4 acc[4][4];
    zero_acc(acc);
    gemm_seg<false, false>(VsT + ((size_t)c * 512 + h * 64) * 256, 256, nullptr, 0, 64,
                           KT0 + ((size_t)((c * 2 + dir) * 8 + h) * 64) * 256, 256, nullptr, 0, 64, 256, acc, lA, lB);
    if (w == 0) {
      float* out = (float*)(ws + OFF_DS0) + (size_t)((c * 8 + h) * 2 + dir) * 4096;
#pragma unroll
      for (int tm = 0; tm < 4; ++tm)
#pragma unroll
        for (int j = 0; j < 4; ++j)
#pragma unroll
          for (int tn = 0; tn < 4; ++tn)
            out[(tm * 16 + (lane >> 4) * 4 + j) * 64 + tn * 16 + (lane & 15)] = acc[tm][tn][j];
    }
  }
}

DI void phase_ssd_scan(const Params& p) {
  unsigned char* ws = p.ws;
  const float* sc = (const float*)(ws + OFF_SC0);
  const size_t NS = (size_t)NTOK * 8;
  const float* CUMF = sc + 4 * NS; const float* CUMB = sc + 5 * NS;
  const float* DS = (const float*)(ws + OFF_DS0);
  bf16_t* SST = (bf16_t*)(ws + OFF_SST0);
  for (int idx = blockIdx.x * 256 + threadIdx.x; idx < 32 * 8 * 2 * 4096; idx += p.gsz * 256) {
    const int e = idx & 4095, dir = (idx >> 12) & 1, h = (idx >> 13) & 7, c = idx >> 16;
    p.out[OUT_SSD + (size_t)((c * 2 + dir) * 8 + h) * 4096 + e] = DS[(size_t)((c * 8 + h) * 2 + dir) * 4096 + (e & 63) * 64 + (e >> 6)];
  }
  for (int idx = blockIdx.x * 256 + threadIdx.x; idx < 131072; idx += p.gsz * 256) {
    const int e = idx & 4095, dir = (idx >> 12) & 1, h = (idx >> 13) & 7, b = idx >> 16;
    float S = p.in[5][(size_t)((b * 2 + dir) * 8 + h) * 4096 + (e & 63) * 64 + (e >> 6)];
    for (int s = 0; s < 16; ++s) {
      const int lc = dir ? 15 - s : s;
      const int c = 32 + b * 16 + lc;
      const size_t o = (size_t)((c * 8 + h) * 2 + dir) * 4096 + e;
      SST[o] = f2bf(S);
      const float tot = dir ? CUMB[(size_t)(c * 256) * 8 + h] : CUMF[(size_t)(c * 256 + 255) * 8 + h];
      S = __expf(tot) * S + DS[o];
    }
  }
}

DI void phase_ssd_y(const Params& p, unsigned char* smem) {
  unsigned char* ws = p.ws;
  bf16_t* lA = (bf16_t*)smem; bf16_t* lB = lA + 128 * LDK;
  const int lane = threadIdx.x & 63, w = threadIdx.x >> 6, wm = w >> 1, wn = w & 1;
  const bf16_t* CC = (const bf16_t*)(ws + OFF_CC);
  const bf16_t* VsT = (const bf16_t*)(ws + OFF_VS);
  const bf16_t* P0 = (const bf16_t*)(ws + OFF_P0);
  const bf16_t* SST = (const bf16_t*)(ws + OFF_SST0);
  const float* sc = (const float*)(ws + OFF_SC0);
  const size_t NS = (size_t)NTOK * 8;
  const float* XS = (const float*)(ws + OFF_XS);
  const bf16_t* Zs = (const bf16_t*)(ws + OFF_ZS);
  float* YG = (float*)(ws + OFF_YG);
  for (int it = blockIdx.x; it < 1024; it += p.gsz) {
    const int c = it >> 4, h = (it >> 1) & 7, ti = it & 1, g = h >> 2, tok0 = c * 256;
    f32x4 acc[4][4];
    zero_acc(acc);
    gemm_seg<false, false>(P0 + ((size_t)(c * 8 + h) * 256 + ti * 128) * 256, 256, nullptr, 0, 128,
                           VsT + ((size_t)c * 512 + h * 64) * 256, 256, nullptr, 0, 64, 256, acc, lA, lB);
    if (c >= 32) {
#pragma unroll 1
      for (int dir = 0; dir < 2; ++dir)
        gemm_seg<false, false>(CC + (size_t)(tok0 + ti * 128) * 128 + g * 64, 128, sc + dir * NS + (size_t)(tok0 + ti * 128) * 8 + h, 8, 128,
                               SST + (size_t)((c * 8 + h) * 2 + dir) * 4096, 64, nullptr, 0, 64, 64, acc, lA, lB);
    }
    if (wn == 0) {
      const float dsk = p.in[20][h];
#pragma unroll
      for (int tm = 0; tm < 4; ++tm)
#pragma unroll
        for (int j = 0; j < 4; ++j) {
          const int tok = tok0 + ti * 128 + wm * 64 + tm * 16 + (lane >> 4) * 4 + j;
#pragma unroll
          for (int tn = 0; tn < 4; ++tn) {
            const size_t o = (size_t)tok * 512 + h * 64 + tn * 16 + (lane & 15);
            const float y = acc[tm][tn][j] + dsk * XS[o];
            YG[o] = y * bf2f(Zs[o]);
          }
        }
    }
  }
}

DI void phase_ssd_norm(const Params& p) {
  unsigned char* ws = p.ws;
  const int lane = threadIdx.x & 63, w = threadIdx.x >> 6;
  const float* YG = (const float*)(ws + OFF_YG);
  bf16_t* Aout = (bf16_t*)(ws + OFF_AOUT);
  const float* gain = p.in[21];
  for (int tok = (blockIdx.x * 4 + w) * 2; tok < NTOK; tok += p.gsz * 8) {
    float4 v[2][2];
#pragma unroll
    for (int r = 0; r < 2; ++r)
#pragma unroll
      for (int i = 0; i < 2; ++i) v[r][i] = *(const float4*)(YG + (size_t)(tok + r) * 512 + i * 256 + lane * 4);
#pragma unroll
    for (int r = 0; r < 2; ++r) {
      float ss = 0.f;
#pragma unroll
      for (int i = 0; i < 2; ++i) ss += v[r][i].x * v[r][i].x + v[r][i].y * v[r][i].y + v[r][i].z * v[r][i].z + v[r][i].w * v[r][i].w;
      ss = wave_sum(ss);
      const float rinv = rsqrtf(ss * (1.f / 512.f) + EPSF);
#pragma unroll
      for (int i = 0; i < 2; ++i) {
        const int col = i * 256 + lane * 4;
        const float4 g = *(const float4*)(gain + col);
        uint2 pk;
        pk.x = pack2(v[r][i].x * rinv * g.x, v[r][i].y * rinv * g.y);
        pk.y = pack2(v[r][i].z * rinv * g.z, v[r][i].w * rinv * g.w);
        *(uint2*)(Aout + (size_t)(tok + r) * DM + 512 + col) = pk;
      }
    }
  }
}

DI void phase_res_gemm(const Params& p, const bf16_t* A, int lda, int K, const bf16_t* W, const float* xsrc, int layer, int gate_idx, unsigned char* smem) {
  unsigned char* ws = p.ws;
  bf16_t* lA = (bf16_t*)smem; bf16_t* lB = lA + 256 * LDK2;
  const int lane = threadIdx.x & 63, w = threadIdx.x >> 6, wm = w >> 1, wn = w & 1;
  float* X = (float*)(ws + OFF_X);
  const float* mod = (const float*)(ws + OFF_MOD) + (size_t)layer * 3 * 6144 + gate_idx * 1024;
  for (int it = blockIdx.x; it < 64 * 8; it += p.gsz) {
    const int tl_ = xcd_tile(it, 64 * 8); const int rt = tl_ >> 3, ct = tl_ & 7;
    f32x4 acc[8][4];
    zero_acc8(acc);
    gemm256(A + (size_t)rt * 256 * lda, lda, W + (size_t)ct * 128 * K, K, K, acc, lA, lB);
    const int row0 = rt * 256 + wm * 128;
    const float* xb = xsrc ? xsrc : (row0 < NCTX ? p.in[0] : p.in[1] - (size_t)NCTX * DM);
    const int ncol = ct * 128 + wn * 64 + (lane & 15);
    const float* gt = mod + cond_row(row0) * 6144 + ncol;
    float gv[4];
#pragma unroll
    for (int tn = 0; tn < 4; ++tn) gv[tn] = gt[tn * 16];
#pragma unroll
    for (int tm = 0; tm < 8; ++tm)
#pragma unroll
      for (int j = 0; j < 4; ++j) {
        const size_t o = (size_t)(row0 + tm * 16 + (lane >> 4) * 4 + j) * DM + ncol;
#pragma unroll
        for (int tn = 0; tn < 4; ++tn) X[o + tn * 16] = xb[o + tn * 16] + gv[tn] * acc[tm][tn][j];
      }
  }
}

DI void phase_ffn_gu(const Params& p, const bf16_t* W, unsigned char* smem) {
  unsigned char* ws = p.ws;
  bf16_t* lA = (bf16_t*)smem; bf16_t* lB = lA + 256 * LDK2;
  const int lane = threadIdx.x & 63, w = threadIdx.x >> 6, wm = w >> 1, wn = w & 1;
  const bf16_t* H = (const bf16_t*)(ws + OFF_H);
  bf16_t* HFF = (bf16_t*)(ws + OFF_HFF);
  for (int it = blockIdx.x; it < 64 * 44; it += p.gsz) {
    const int tl_ = xcd_tile(it, 64 * 44); const int rt = tl_ / 44, ct = tl_ % 44;
    f32x4 acc[8][4];
    zero_acc8(acc);
    gemm256(H + (size_t)rt * 256 * DM, DM, W + (size_t)ct * 128 * DM, DM, DM, acc, lA, lB);
#pragma unroll
    for (int tm = 0; tm < 8; ++tm)
#pragma unroll
      for (int j = 0; j < 4; ++j) {
        const int tok = rt * 256 + wm * 128 + tm * 16 + (lane >> 4) * 4 + j;
#pragma unroll
        for (int pp = 0; pp < 2; ++pp) {
          const int np = ct * 128 + wn * 64 + pp * 32;
          const int col = (np >> 5) * 16 + (lane & 15);
          const float gv = acc[tm][2 * pp][j], uv = acc[tm][2 * pp + 1][j];
          HFF[(size_t)tok * DFF + col] = f2bf(siluf(gv) * uv);
        }
      }
  }
}

DI void phase_l1_inproj(const Params& p, unsigned char* smem) {
  unsigned char* ws = p.ws;
  bf16_t* lA = (bf16_t*)smem; bf16_t* lB = lA + 256 * LDK2;
  const int lane = threadIdx.x & 63, w = threadIdx.x >> 6, wm = w >> 1, wn = w & 1;
  const int c = lane & 15;
  const bf16_t* H = (const bf16_t*)(ws + OFF_H);
  const bf16_t* W = (const bf16_t*)(ws + OFF_WIN1);
  bf16_t* Q1 = (bf16_t*)(ws + OFF_Q1); bf16_t* K1 = (bf16_t*)(ws + OFF_K1);
  bf16_t* VT = (bf16_t*)(ws + OFF_V1); bf16_t* G1 = (bf16_t*)(ws + OFF_G1);
  bf16_t* KTf = (bf16_t*)(ws + OFF_R4 + 64 * MBy); bf16_t* KTb = KTf + (size_t)64 * 1024 * 256;
  const float* scw = (const float*)(ws + OFF_SC1); const size_t NS1 = (size_t)NTOK * 4;
  const float2* rope1 = (const float2*)(ws + OFF_ROPE1);
  for (int it = blockIdx.x; it < 64 * 48; it += p.gsz) {
    const int tl_ = xcd_tile(it, 64 * 48); const int rt = tl_ / 48, ct = tl_ % 48;
    f32x4 acc[8][4];
    zero_acc8(acc);
    gemm256(H + (size_t)rt * 256 * DM, DM, W + (size_t)ct * 128 * DM, DM, DM, acc, lA, lB);
    const int row0 = rt * 256 + wm * 128, col0 = ct * 128 + wn * 64;
    const bool lat = row0 >= NCTX;
    if (col0 < 1024) {
      const int head = col0 >> 8, pos0 = col0 & 255;
#pragma unroll
      for (int pp = 0; pp < 2; ++pp) {
        const int i = ((pos0 >> 5) + pp) * 16 + c;
#pragma unroll
        for (int tm = 0; tm < 8; ++tm) {
#pragma unroll
          for (int j = 0; j < 4; ++j) {
            const int tok = row0 + tm * 16 + (lane >> 4) * 4 + j;
            float x1 = acc[tm][2 * pp][j], x2 = acc[tm][2 * pp + 1][j];
            if (lat) {
              const int tl = (tok - NCTX) & 4095;
              const float2 t = rope1[((i < 64) ? (tl >> 6) : (tl & 63)) * 64 + (i & 63)];
              const float z1 = x1 * t.x - x2 * t.y, z2 = x2 * t.x + x1 * t.y;
              x1 = z1; x2 = z2;
            }
            bf16_t* d = Q1 + (size_t)tok * 1024 + head * 256;
            d[i] = f2bf(x1); d[128 + i] = f2bf(x2);
          }
          asm volatile("" ::: "memory");
        }
      }
    } else if (col0 < 2048) {
      const int head = (col0 - 1024) >> 8, pos0 = col0 & 255;
#pragma unroll
      for (int tm = 0; tm < 8; ++tm) {
        const int t0 = row0 + tm * 16 + (lane >> 4) * 4;
        const int ch = t0 >> 8, tl0 = t0 & 255;
        float wf[4], wb[4];
#pragma unroll
        for (int j = 0; j < 4; ++j) { wf[j] = scw[2 * NS1 + (size_t)(t0 + j) * 4 + head]; wb[j] = scw[3 * NS1 + (size_t)(t0 + j) * 4 + head]; }
#pragma unroll
        for (int pp = 0; pp < 2; ++pp) {
          const int i = ((pos0 >> 5) + pp) * 16 + c;
          float y1[4], y2[4];
#pragma unroll
          for (int j = 0; j < 4; ++j) {
            const int tok = t0 + j;
            float x1 = acc[tm][2 * pp][j] * 0.0625f, x2 = acc[tm][2 * pp + 1][j] * 0.0625f;
            if (lat) {
              const int tl = (tok - NCTX) & 4095;
              const float2 t = rope1[((i < 64) ? (tl >> 6) : (tl & 63)) * 64 + (i & 63)];
              const float z1 = x1 * t.x - x2 * t.y, z2 = x2 * t.x + x1 * t.y;
              x1 = z1; x2 = z2;
            }
            y1[j] = x1; y2[j] = x2;
            bf16_t* d = K1 + (size_t)tok * 1024 + head * 256;
            d[i] = f2bf(x1); d[128 + i] = f2bf(x2);
          }
          const size_t r1 = ((size_t)ch * 1024 + head * 256 + i) * 256 + tl0, r2 = r1 + (size_t)128 * 256;
          uint2 u;
          u.x = pack2(y1[0] * wf[0], y1[1] * wf[1]); u.y = pack2(y1[2] * wf[2], y1[3] * wf[3]); *(uint2*)(KTf + r1) = u;
          u.x = pack2(y2[0] * wf[0], y2[1] * wf[1]); u.y = pack2(y2[2] * wf[2], y2[3] * wf[3]); *(uint2*)(KTf + r2) = u;
          u.x = pack2(y1[0] * wb[0], y1[1] * wb[1]); u.y = pack2(y1[2] * wb[2], y1[3] * wb[3]); *(uint2*)(KTb + r1) = u;
          u.x = pack2(y2[0] * wb[0], y2[1] * wb[1]); u.y = pack2(y2[2] * wb[2], y2[3] * wb[3]); *(uint2*)(KTb + r2) = u;
        }
        asm volatile("" ::: "memory");
      }
    } else if (col0 < 4096) {
      const int cb = col0 - 2048;
#pragma unroll
      for (int tm = 0; tm < 8; ++tm) {
        const int t0 = row0 + tm * 16 + (lane >> 4) * 4;
        const int ch = t0 >> 8, tl0 = t0 & 255;
#pragma unroll
        for (int tn = 0; tn < 4; ++tn) {
          uint2 u;
          u.x = pack2(acc[tm][tn][0], acc[tm][tn][1]); u.y = pack2(acc[tm][tn][2], acc[tm][tn][3]);
          *(uint2*)(VT + ((size_t)ch * 2048 + cb + tn * 16 + c) * 256 + tl0) = u;
        }
      }
    } else {
      const int cb = col0 - 4096;
#pragma unroll
      for (int tm = 0; tm < 8; ++tm)
#pragma unroll
        for (int j = 0; j < 4; ++j) {
          const int tok = row0 + tm * 16 + (lane >> 4) * 4 + j;
#pragma unroll
          for (int tn = 0; tn < 4; ++tn)
            G1[(size_t)tok * 2048 + cb + tn * 16 + c] = f2bf(siluf(acc[tm][tn][j]));
        }
    }
  }
}

DI void phase_ret_pds(const Params& p, unsigned char* smem) {
  unsigned char* ws = p.ws;
  const bf16_t* Q1 = (const bf16_t*)(ws + OFF_Q1);
  const bf16_t* K1 = (const bf16_t*)(ws + OFF_K1);
  const bf16_t* VT = (const bf16_t*)(ws + OFF_V1);
  const bf16_t* KTf = (const bf16_t*)(ws + OFF_R4 + 64 * MBy);
  const bf16_t* KTb = KTf + (size_t)64 * 1024 * 256;
  const float* sc = (const float*)(ws + OFF_SC1);
#pragma unroll 1
  for (int it = blockIdx.x; it < 4096; it += p.gsz) {
    const int t8 = it & 7, dir = (it >> 3) & 1, h = (it >> 4) & 3, c = it >> 6;
    const bf16_t* kt = (dir ? KTb : KTf) + ((size_t)c * 1024 + h * 256) * 256;
    const bf16_t* vt = VT + ((size_t)c * 2048 + h * 512) * 256;
    if (c < 32) {
      float* out = p.out + OUT_RET + (size_t)((c * 2 + dir) * 4 + h) * 131072;
      dsgemm_nt_tile(kt, vt, t8 >> 2, t8 & 3, out, nullptr, 512, smem);
    } else {
      const int b = (c - 32) >> 4, lc = (c - 32) & 15;
      bf16_t* outb = (bf16_t*)(ws + OFF_DS1) + (size_t)(((b * 16 + lc) * 4 + h) * 2 + dir) * 131072;
      dsgemm_nt_tile(vt, kt, t8 >> 1, t8 & 1, nullptr, outb, 256, smem);
    }
  }
#pragma unroll 1
  for (int i = blockIdx.x; i < 1024; i += p.gsz) {
    const int c = i >> 4, h = (i >> 2) & 3, ti = (i >> 1) & 1, tj = i & 1, tok0 = c * 256;
    pgemm_tile(Q1 + (size_t)tok0 * 1024 + h * 256, 1024, K1 + (size_t)tok0 * 1024 + h * 256, 1024, 256, sc, 4, h, tok0, ti, tj,
               (bf16_t*)(ws + OFF_P1) + (size_t)(c * 4 + h) * 65536, smem);
  }
}

DI void phase_ret_scan(const Params& p) {
  unsigned char* ws = p.ws;
  const float* sc = (const float*)(ws + OFF_SC1);
  const size_t NS = (size_t)NTOK * 4;
  const float* CUMF = sc + 4 * NS; const float* CUMB = sc + 5 * NS;
  const bf16_t* DS = (const bf16_t*)(ws + OFF_DS1);
  bf16_t* SST0p = (bf16_t*)(ws + OFF_K1); bf16_t* SST1p = (bf16_t*)(ws + OFF_SST1B);
  for (int idx = blockIdx.x * 256 + threadIdx.x; idx < 2097152; idx += p.gsz * 256) {
    const int e = idx & 131071, dir = (idx >> 17) & 1, h = (idx >> 18) & 3, b = idx >> 20;
    float S = p.in[6][(size_t)((b * 2 + dir) * 4 + h) * 131072 + (size_t)(e & 255) * 512 + (e >> 8)];
    float dsv[16];
#pragma unroll
    for (int s = 0; s < 16; ++s) {
      const int lc = dir ? 15 - s : s;
      dsv[s] = bf2f(DS[(size_t)(((b * 16 + lc) * 4 + h) * 2 + dir) * 131072 + e]);
    }
    const int c0 = 32 + b * 16;
    const float dec = __expf(dir ? CUMB[(size_t)(c0 * 256) * 4 + h] : CUMF[(size_t)(c0 * 256 + 255) * 4 + h]);
    bf16_t* dst = b ? SST1p : SST0p;
#pragma unroll
    for (int s = 0; s < 16; ++s) {
      const int lc = dir ? 15 - s : s;
      dst[(size_t)((lc * 4 + h) * 2 + dir) * 131072 + e] = f2bf(S);
      S = dec * S + dsv[s];
    }
  }
}

DI void phase_ret_y(const Params& p, unsigned char* smem) {
  unsigned char* ws = p.ws;
  bf16_t* lA = (bf16_t*)smem; bf16_t* lB = lA + 128 * LDK;
  const int lane = threadIdx.x & 63, w = threadIdx.x >> 6, wm = w >> 1, wn = w & 1;
  const bf16_t* Q1 = (const bf16_t*)(ws + OFF_Q1);
  const bf16_t* VT = (const bf16_t*)(ws + OFF_V1);
  const bf16_t* P1 = (const bf16_t*)(ws + OFF_P1);
  const bf16_t* SST0p = (const bf16_t*)(ws + OFF_K1); const bf16_t* SST1p = (const bf16_t*)(ws + OFF_SST1B);
  const float* sc = (const float*)(ws + OFF_SC1);
  const size_t NS = (size_t)NTOK * 4;
  bf16_t* Y1 = (bf16_t*)(ws + OFF_Y1);
  for (int it = blockIdx.x; it < 2048; it += p.gsz) {
    const int tni = it & 3, ti = (it >> 2) & 1, h = (it >> 3) & 3, c = it >> 5, tok0 = c * 256;
    f32x4 acc[4][4];
    zero_acc(acc);
    gemm_seg<false, false>(P1 + ((size_t)(c * 4 + h) * 256 + ti * 128) * 256, 256, nullptr, 0, 128,
                           VT + ((size_t)c * 2048 + h * 512 + tni * 128) * 256, 256, nullptr, 0, 128, 256, acc, lA, lB);
    if (c >= 32) {
      const int b = (c - 32) >> 4, lc = (c - 32) & 15;
#pragma unroll 1
      for (int dir = 0; dir < 2; ++dir)
        gemm_seg<false, false>(Q1 + (size_t)(tok0 + ti * 128) * 1024 + h * 256, 1024, sc + dir * NS + (size_t)(tok0 + ti * 128) * 4 + h, 4, 128,
                               (b ? SST1p : SST0p) + (size_t)((lc * 4 + h) * 2 + dir) * 131072 + (size_t)tni * 128 * 256, 256, nullptr, 0, 128, 256, acc, lA, lB);
    }
#pragma unroll
    for (int tm = 0; tm < 4; ++tm)
#pragma unroll
      for (int j = 0; j < 4; ++j) {
        const int tok = tok0 + ti * 128 + wm * 64 + tm * 16 + (lane >> 4) * 4 + j;
#pragma unroll
        for (int tn = 0; tn < 4; ++tn)
          Y1[(size_t)tok * 2048 + h * 512 + tni * 128 + wn * 64 + tn * 16 + (lane & 15)] = f2bf(acc[tm][tn][j]);
      }
  }
}

DI void phase_ret_norm(const Params& p) {
  unsigned char* ws = p.ws;
  const int lane = threadIdx.x & 63, w = threadIdx.x >> 6;
  const bf16_t* Y1 = (const bf16_t*)(ws + OFF_Y1);
  const bf16_t* G1 = (const bf16_t*)(ws + OFF_G1);
  bf16_t* A2 = (bf16_t*)(ws + OFF_A2);
  const float* gain = p.in[32];
  for (int tok = blockIdx.x * 4 + w; tok < NTOK; tok += p.gsz * 4) {
    const size_t base = (size_t)tok * 2048;
    float4 v[4][2];
    uint2 gg[4][2];
#pragma unroll
    for (int h = 0; h < 4; ++h)
#pragma unroll
      for (int i = 0; i < 2; ++i) {
        { const uint2 yy = *(const uint2*)(Y1 + base + h * 512 + i * 256 + lane * 4);
          v[h][i] = make_float4(__uint_as_float(yy.x << 16), __uint_as_float(yy.x & 0xffff0000u), __uint_as_float(yy.y << 16), __uint_as_float(yy.y & 0xffff0000u)); }
        gg[h][i] = *(const uint2*)(G1 + base + h * 512 + i * 256 + lane * 4);
      }
#pragma unroll
    for (int h = 0; h < 4; ++h) {
      float ss = 0.f;
#pragma unroll
      for (int i = 0; i < 2; ++i) ss += v[h][i].x * v[h][i].x + v[h][i].y * v[h][i].y + v[h][i].z * v[h][i].z + v[h][i].w * v[h][i].w;
      ss = wave_sum(ss);
      const float rinv = rsqrtf(ss * (1.f / 512.f) + EPSF);
#pragma unroll
      for (int i = 0; i < 2; ++i) {
        const int col = h * 512 + i * 256 + lane * 4;
        const float4 g = *(const float4*)(gain + col);
        uint2 pk;
        pk.x = pack2(v[h][i].x * rinv * g.x * __uint_as_float(gg[h][i].x << 16), v[h][i].y * rinv * g.y * __uint_as_float(gg[h][i].x & 0xffff0000u));
        pk.y = pack2(v[h][i].z * rinv * g.z * __uint_as_float(gg[h][i].y << 16), v[h][i].w * rinv * g.w * __uint_as_float(gg[h][i].y & 0xffff0000u));
        *(uint2*)(A2 + base + col) = pk;
      }
    }
  }
}

DI void phase_final(const Params& p) {
  const int lane = threadIdx.x & 63, w = threadIdx.x >> 6;
  const float* X = (const float*)(p.ws + OFF_X);
  const float* gain = p.in[36];
  for (int tok = (blockIdx.x * 4 + w) * 2; tok < NTOK; tok += p.gsz * 8) {
    float4 v[2][4];
#pragma unroll
    for (int r = 0; r < 2; ++r)
#pragma unroll
      for (int i = 0; i < 4; ++i) v[r][i] = *(const float4*)(X + (size_t)(tok + r) * DM + i * 256 + lane * 4);
    float rinv[2];
#pragma unroll
    for (int r = 0; r < 2; ++r) {
      float ss = 0.f;
#pragma unroll
      for (int i = 0; i < 4; ++i) ss += v[r][i].x * v[r][i].x + v[r][i].y * v[r][i].y + v[r][i].z * v[r][i].z + v[r][i].w * v[r][i].w;
      ss = wave_sum(ss);
      rinv[r] = rsqrtf(ss * (1.f / 1024.f) + EPSF);
    }
#pragma unroll
    for (int i = 0; i < 4; ++i) {
      const int col = i * 256 + lane * 4;
      const float4 g = *(const float4*)(gain + col);
#pragma unroll
      for (int r = 0; r < 2; ++r) {
        float4 o;
        o.x = v[r][i].x * rinv[r] * g.x; o.y = v[r][i].y * rinv[r] * g.y; o.z = v[r][i].z * rinv[r] * g.z; o.w = v[r][i].w * rinv[r] * g.w;
        float* yo = p.out + OUT_Y + (size_t)(tok + r) * DM + col;
        __builtin_nontemporal_store(o.x, yo); __builtin_nontemporal_store(o.y, yo + 1);
        __builtin_nontemporal_store(o.z, yo + 2); __builtin_nontemporal_store(o.w, yo + 3);
      }
    }
  }
}

#define XB_TMO      128
#define XB_XCNT(j)  (256  + 64 * (j))
#define XB_XSUB(j)  (1280 + 64 * (j))
#define XB_XGEN(j)  (2304 + 64 * (j))
#define XB_TOP      3328
#define XB_TOPGEN   3392
#define XCD_BAR_WORDS 3456
#define XB_SPIN_CAP (1u << 22)
#define LAS __attribute__((address_space(3)))
DI unsigned xb_ld(unsigned* p) { return __hip_atomic_load(p, __ATOMIC_RELAXED, __HIP_MEMORY_SCOPE_AGENT); }
DI unsigned xb_add(unsigned* p, unsigned v) { return __hip_atomic_fetch_add(p, v, __ATOMIC_RELAXED, __HIP_MEMORY_SCOPE_AGENT); }
DI unsigned xb_xcc_id() { return (unsigned)__builtin_amdgcn_s_getreg((3 << 11) | 20) & 0xFu; }
#define XB_SPIN(cond, bar) do { unsigned _sp = 0; while (cond) { __builtin_amdgcn_s_sleep(1); \
    if ((++_sp & 255u) == 0u) { if (xb_ld(&(bar)[XB_TMO])) break; if (_sp > XB_SPIN_CAP) { atomicAdd(&(bar)[XB_TMO], 1u); break; } } } } while (0)
struct XcdBarrier { unsigned* bar; unsigned x; volatile unsigned* st; };
DI XcdBarrier xcd_barrier_post(unsigned* bar, volatile unsigned* st) {
  XcdBarrier b; b.bar = bar; b.x = xb_xcc_id(); b.st = st;
  if (threadIdx.x == 0) (void)xb_add(&bar[XB_XCNT(b.x)], 1u);
  return b;
}
DI void xcd_barrier_complete(unsigned* bar, unsigned x, unsigned& nloc, unsigned& nx) {
  const unsigned G = gridDim.x;
  unsigned sum, cnt, mine, sp = 0u;
  for (;;) {
    sum = 0u; cnt = 0u; mine = 0u;
#pragma unroll
    for (unsigned j = 0; j < 16; ++j) { const unsigned c = xb_ld(&bar[XB_XCNT(j)]); sum += c; cnt += (c > 0u) ? 1u : 0u; mine = (j == x) ? c : mine; }
    if (sum == G) break;
    __builtin_amdgcn_s_sleep(1);
    if ((++sp & 255u) == 0u) { if (xb_ld(&bar[XB_TMO])) break; if (sp > XB_SPIN_CAP) { atomicAdd(&bar[XB_TMO], 1u); break; } }
  }
  nloc = mine > 0u ? mine : 1u; nx = cnt > 0u ? cnt : 1u;
}
DI void xcd_barrier(const XcdBarrier& b) {
  asm volatile("s_waitcnt vmcnt(0)" ::: "memory");
  __syncthreads();
  if (threadIdx.x == 0) {
    unsigned* bar = b.bar;
    __builtin_amdgcn_s_waitcnt(0);
    unsigned nloc = b.st[0], nx = b.st[1];
    if (nloc == 0u) { xcd_barrier_complete(bar, b.x, nloc, nx); b.st[0] = nloc; b.st[1] = nx; }
    const unsigned old = xb_add(&bar[XB_XSUB(b.x)], 1u);
    const unsigned gen = old / nloc;
    if (old + 1u == (gen + 1u) * nloc) {
      __builtin_amdgcn_fence(__ATOMIC_RELEASE, "agent");
      asm volatile("s_waitcnt vmcnt(0)" ::: "memory");
      const unsigned og = xb_add(&bar[XB_TOP], 1u);
      const unsigned tg = og / nx;
      if (og + 1u == (tg + 1u) * nx) xb_add(&bar[XB_TOPGEN], 1u);
      else XB_SPIN(xb_ld(&bar[XB_TOPGEN]) == tg, bar);
      __builtin_amdgcn_fence(__ATOMIC_ACQUIRE, "agent");
      xb_add(&bar[XB_XGEN(b.x)], 1u);
      asm volatile("s_waitcnt vmcnt(0)" ::: "memory");
    } else {
      XB_SPIN(xb_ld(&bar[XB_XGEN(b.x)]) == gen, bar);
      __builtin_amdgcn_fence(__ATOMIC_ACQUIRE, "agent");
      asm volatile("s_waitcnt vmcnt(0)" ::: "memory");
    }
  }
  __syncthreads();
}

__global__ void __launch_bounds__(256, LB_MIN) mega(Params p) {
  __shared__ __attribute__((aligned(16))) unsigned char smem[40960];
  __shared__ __attribute__((aligned(16))) unsigned bar_st[4];
  cg::grid_group grid = cg::this_grid();
  unsigned char* ws = p.ws;
#if ONE_LAUNCH
  if (threadIdx.x == 0) { bar_st[0] = 0u; bar_st[1] = 0u; }
  __syncthreads();
  const XcdBarrier xb = xcd_barrier_post((unsigned*)(ws + OFF_BAR), bar_st);
#endif
#if ONE_LAUNCH
  p.gsz = ((PH_LIMIT_MASK >> 0) & 1) ? (int)(gridDim.x >> 1) : (int)gridDim.x;
  if ((int)blockIdx.x < p.gsz)
  {phase0(p, smem); }
  xcd_barrier(xb);
  if (p.ph_lo < 0) grid.sync();
  p.gsz = ((PH_LIMIT_MASK >> 1) & 1) ? (int)(gridDim.x >> 1) : (int)gridDim.x;
  if ((int)blockIdx.x < p.gsz)
  {phase_normmod(p, nullptr, p.in[10], 0, 0, 1); }
  xcd_barrier(xb);
  p.gsz = ((PH_LIMIT_MASK >> 2) & 1) ? (int)(gridDim.x >> 1) : (int)gridDim.x;
  if ((int)blockIdx.x < p.gsz)
  {phase_l0_inproj(p, smem); }
  xcd_barrier(xb);
  p.gsz = ((PH_LIMIT_MASK >> 3) & 1) ? (int)(gridDim.x >> 1) : (int)gridDim.x;
  if ((int)blockIdx.x < p.gsz)
  {for (int it = blockIdx.x; it < 640 + 1024; it += p.gsz) {
          if (it < 640) ssd_prep_item(p, it, smem);
          else attn_item(p, it - 640, smem);
        } }
  xcd_barrier(xb);
  p.gsz = ((PH_LIMIT_MASK >> 4) & 1) ? (int)(gridDim.x >> 1) : (int)gridDim.x;
  if ((int)blockIdx.x < p.gsz)
  {phase_ssd_pds(p, smem); }
  xcd_barrier(xb);
  p.gsz = ((PH_LIMIT_MASK >> 5) & 1) ? (int)(gridDim.x >> 1) : (int)gridDim.x;
  if ((int)blockIdx.x < p.gsz)
  {phase_ssd_scan(p); }
  xcd_barrier(xb);
  p.gsz = ((PH_LIMIT_MASK >> 6) & 1) ? (int)(gridDim.x >> 1) : (int)gridDim.x;
  if ((int)blockIdx.x < p.gsz)
  {phase_ssd_y(p, smem); }
  xcd_barrier(xb);
  p.gsz = ((PH_LIMIT_MASK >> 7) & 1) ? (int)(gridDim.x >> 1) : (int)gridDim.x;
  if ((int)blockIdx.x < p.gsz)
  {phase_ssd_norm(p); }
  xcd_barrier(xb);
  p.gsz = ((PH_LIMIT_MASK >> 8) & 1) ? (int)(gridDim.x >> 1) : (int)gridDim.x;
  if ((int)blockIdx.x < p.gsz)
  {phase_res_gemm(p, (const bf16_t*)(ws + OFF_AOUT), DM, DM, (const bf16_t*)(ws + OFF_WOUT0), nullptr, 0, 2, smem); }
  xcd_barrier(xb);
  p.gsz = ((PH_LIMIT_MASK >> 9) & 1) ? (int)(gridDim.x >> 1) : (int)gridDim.x;
  if ((int)blockIdx.x < p.gsz)
  {phase_normmod(p, (const float*)(ws + OFF_X), p.in[11], 0, 3, 4); }
  xcd_barrier(xb);
  p.gsz = ((PH_LIMIT_MASK >> 10) & 1) ? (int)(gridDim.x >> 1) : (int)gridDim.x;
  if ((int)blockIdx.x < p.gsz)
  {phase_ffn_gu(p, (const bf16_t*)(ws + OFF_WGU0), smem); }
  xcd_barrier(xb);
  p.gsz = ((PH_LIMIT_MASK >> 11) & 1) ? (int)(gridDim.x >> 1) : (int)gridDim.x;
  if ((int)blockIdx.x < p.gsz)
  {phase_res_gemm(p, (const bf16_t*)(ws + OFF_HFF), DFF, DFF, (const bf16_t*)(ws + OFF_WDN0), (const float*)(ws + OFF_X), 0, 5, smem); }
  xcd_barrier(xb);
  p.gsz = ((PH_LIMIT_MASK >> 12) & 1) ? (int)(gridDim.x >> 1) : (int)gridDim.x;
  if ((int)blockIdx.x < p.gsz)
  {phase_normmod(p, (const float*)(ws + OFF_X), p.in[27], 1, 0, 1); }
  xcd_barrier(xb);
  p.gsz = ((PH_LIMIT_MASK >> 13) & 1) ? (int)(gridDim.x >> 1) : (int)gridDim.x;
  if ((int)blockIdx.x < p.gsz)
  {phase_l1_inproj(p, smem); }
  xcd_barrier(xb);
  p.gsz = ((PH_LIMIT_MASK >> 14) & 1) ? (int)(gridDim.x >> 1) : (int)gridDim.x;
  if ((int)blockIdx.x < p.gsz)
  {phase_ret_pds(p, smem); }
  xcd_barrier(xb);
  p.gsz = ((PH_LIMIT_MASK >> 15) & 1) ? (int)(gridDim.x >> 1) : (int)gridDim.x;
  if ((int)blockIdx.x < p.gsz)
  {phase_ret_scan(p); }
  xcd_barrier(xb);
  p.gsz = ((PH_LIMIT_MASK >> 16) & 1) ? (int)(gridDim.x >> 1) : (int)gridDim.x;
  if ((int)blockIdx.x < p.gsz)
  {phase_ret_y(p, smem); }
  xcd_barrier(xb);
  p.gsz = ((PH_LIMIT_MASK >> 17) & 1) ? (int)(gridDim.x >> 1) : (int)gridDim.x;
  if ((int)blockIdx.x < p.gsz)
  {phase_ret_norm(p); }
  xcd_barrier(xb);
  p.gsz = ((PH_LIMIT_MASK >> 18) & 1) ? (int)(gridDim.x >> 1) : (int)gridDim.x;
  if ((int)blockIdx.x < p.gsz)
  {phase_res_gemm(p, (const bf16_t*)(ws + OFF_A2), 2048, 2048, (const bf16_t*)(ws + OFF_WOUT1), (const float*)(ws + OFF_X), 1, 2, smem); }
  xcd_barrier(xb);
  p.gsz = ((PH_LIMIT_MASK >> 19) & 1) ? (int)(gridDim.x >> 1) : (int)gridDim.x;
  if ((int)blockIdx.x < p.gsz)
  {phase_normmod(p, (const float*)(ws + OFF_X), p.in[28], 1, 3, 4); }
  xcd_barrier(xb);
  p.gsz = ((PH_LIMIT_MASK >> 20) & 1) ? (int)(gridDim.x >> 1) : (int)gridDim.x;
  if ((int)blockIdx.x < p.gsz)
  {phase_ffn_gu(p, (const bf16_t*)(ws + OFF_WGU1), smem); }
  xcd_barrier(xb);
  p.gsz = ((PH_LIMIT_MASK >> 21) & 1) ? (int)(gridDim.x >> 1) : (int)gridDim.x;
  if ((int)blockIdx.x < p.gsz)
  {phase_res_gemm(p, (const bf16_t*)(ws + OFF_HFF), DFF, DFF, (const bf16_t*)(ws + OFF_WDN1), (const float*)(ws + OFF_X), 1, 5, smem); }
  xcd_barrier(xb);
  p.gsz = ((PH_LIMIT_MASK >> 22) & 1) ? (int)(gridDim.x >> 1) : (int)gridDim.x;
  if ((int)blockIdx.x < p.gsz)
  {phase_final(p); }
#else
  p.gsz = gridDim.x;
  switch (p.ph_lo) {
    case 0: {phase0(p, smem); } break;
    case 1: {phase_normmod(p, nullptr, p.in[10], 0, 0, 1); } break;
    case 2: {phase_l0_inproj(p, smem); } break;
    case 3: {for (int it = blockIdx.x; it < 640 + 1024; it += p.gsz) {
          if (it < 640) ssd_prep_item(p, it, smem);
          else attn_item(p, it - 640, smem);
        } } break;
    case 4: {phase_ssd_pds(p, smem); } break;
    case 5: {phase_ssd_scan(p); } break;
    case 6: {phase_ssd_y(p, smem); } break;
    case 7: {phase_ssd_norm(p); } break;
    case 8: {phase_res_gemm(p, (const bf16_t*)(ws + OFF_AOUT), DM, DM, (const bf16_t*)(ws + OFF_WOUT0), nullptr, 0, 2, smem); } break;
    case 9: {phase_normmod(p, (const float*)(ws + OFF_X), p.in[11], 0, 3, 4); } break;
    case 10: {phase_ffn_gu(p, (const bf16_t*)(ws + OFF_WGU0), smem); } break;
    case 11: {phase_res_gemm(p, (const bf16_t*)(ws + OFF_HFF), DFF, DFF, (const bf16_t*)(ws + OFF_WDN0), (const float*)(ws + OFF_X), 0, 5, smem); } break;
    case 12: {phase_normmod(p, (const float*)(ws + OFF_X), p.in[27], 1, 0, 1); } break;
    case 13: {phase_l1_inproj(p, smem); } break;
    case 14: {phase_ret_pds(p, smem); } break;
    case 15: {phase_ret_scan(p); } break;
    case 16: {phase_ret_y(p, smem); } break;
    case 17: {phase_ret_norm(p); } break;
    case 18: {phase_res_gemm(p, (const bf16_t*)(ws + OFF_A2), 2048, 2048, (const bf16_t*)(ws + OFF_WOUT1), (const float*)(ws + OFF_X), 1, 2, smem); } break;
    case 19: {phase_normmod(p, (const float*)(ws + OFF_X), p.in[28], 1, 3, 4); } break;
    case 20: {phase_ffn_gu(p, (const bf16_t*)(ws + OFF_WGU1), smem); } break;
    case 21: {phase_res_gemm(p, (const bf16_t*)(ws + OFF_HFF), DFF, DFF, (const bf16_t*)(ws + OFF_WDN1), (const float*)(ws + OFF_X), 1, 5, smem); } break;
    case 22: {phase_final(p); } break;
    default: break;
  }
  if (p.ph_hi < 0) grid.sync();
#endif
}

__global__ void trap_kernel() { __builtin_trap(); }

extern "C" void kernel_launch(void* const* d_in, const int* in_sizes, int n_in, void* d_out, int out_size, void* d_ws, size_t ws_size,
                              hipStream_t stream) {
  if (ws_size < WS_NEED || n_in != 37) {
    fprintf(stderr, "kernel_launch: workspace too small (%zu < %zu) or n_in %d != 37\n", ws_size, (size_t)WS_NEED, n_in);
    hipLaunchKernelGGL(trap_kernel, dim3(1), dim3(64), 0, stream);
    return;
  }
  static int grid_blocks = 0;
  if (!grid_blocks) {
    int dev = 0, cus = 0, per_cu = 0;
    hipGetDevice(&dev);
    hipDeviceGetAttribute(&cus, hipDeviceAttributeMultiprocessorCount, dev);
    hipOccupancyMaxActiveBlocksPerMultiprocessor(&per_cu, (const void*)mega, 256, 0);
    if (per_cu < 1) per_cu = 1;
    if (per_cu > 2) per_cu = 2;
    grid_blocks = cus * per_cu;
  }
  Params p{};
  for (int i = 0; i < 37; ++i) p.in[i] = (const float*)d_in[i];
  p.out = (float*)d_out;
  p.ws = (unsigned char*)d_ws;
#if ONE_LAUNCH
  p.ph_lo = 0; p.ph_hi = NPH;
  (void)hipMemsetAsync((unsigned char*)d_ws + OFF_BAR, 0, XCD_BAR_WORDS * 4, stream);
  void* args[] = {&p};
  hipError_t e = hipLaunchCooperativeKernel((const void*)mega, dim3(grid_blocks), dim3(256), args, 0, stream);
  if (e != hipSuccess) fprintf(stderr, "cooperative launch failed: %s (grid %d)\n", hipGetErrorString(e), grid_blocks);
#else
  for (int ph = 0; ph < NPH; ++ph) {
    p.ph_lo = ph; p.ph_hi = ph + 1;
    for (int rep = 0; rep <= ((REPEAT_MASK >> ph) & 1) * REPEAT_N; ++rep)
      hipLaunchKernelGGL(mega, dim3(((PH_LIMIT_MASK >> ph) & 1) ? grid_blocks / 2 : grid_blocks), dim3(256), 0, stream, p);
  }
#endif
}
```
